# Optimizing an MI355X kernel written in HIP

```python
import jax, jax.numpy as jnp
from jax import lax
import numpy as np

D_MODEL = 1024
BATCH = 8
SEQ = 8192
DEPTH = 1

MIX_WIDTH = D_MODEL
ATTN_WIDTH = MIX_WIDTH // 2
POOL_WIDTH = MIX_WIDTH - ATTN_WIDTH
N_HEADS = 8
HEAD_DIM = ATTN_WIDTH // N_HEADS
DILATED_BRANCHES = ((128, 1), (512, 4), (2048, 16))
MAX_SPAN = 2048
Q_BLOCK = 128
POOL_WINDOWS = (2, 4, 8, 16)
POOL_GROUP = POOL_WIDTH // len(POOL_WINDOWS)
PEER_HEADS = 8
PEER_NKEYS = 128
PEER_EXPERTS = PEER_NKEYS * PEER_NKEYS
PEER_QDIM = 256
PEER_TOPK = 16
TOKEN_CHUNK = 128
N_MOD = 6
EPS = 1e-6

kernel_name = "hybrid_dilated_attn_pool_peer"


def rmsnorm(x, g):
    xf = x.astype(jnp.float32)
    y = xf * lax.rsqrt(jnp.mean(xf * xf, axis=-1, keepdims=True) + EPS)
    return (y * g.astype(jnp.float32)).astype(x.dtype)


def alibi_slopes(n):
    return jnp.asarray([2.0 ** (-8.0 * (h + 1) / n) for h in range(n)], dtype=jnp.float32)


def dilated_attention(q, k, v):
    B, S, H, hd = q.shape
    nblk = S // Q_BLOCK
    pad = ((0, 0), (MAX_SPAN, 0), (0, 0), (0, 0))
    k_pad = jnp.pad(k, pad)
    v_pad = jnp.pad(v, pad)
    slopes = alibi_slopes(H)
    scale = HEAD_DIM ** -0.5
    qi = jnp.arange(Q_BLOCK)
    branches = []
    for w, d in DILATED_BRANCHES:
        j = jnp.arange(w // d + 1)
        gidx = qi[:, None] + MAX_SPAN - j[None, :] * d
        dist = j * d
        branches.append((gidx, dist))

    def block(idx):
        b = idx // nblk
        start = (idx % nblk) * Q_BLOCK
        qb = lax.dynamic_slice(q, (b, start, 0, 0), (1, Q_BLOCK, H, hd))[0].astype(jnp.float32) * scale
        ks = lax.dynamic_slice(k_pad, (b, start, 0, 0), (1, MAX_SPAN + Q_BLOCK, H, hd))[0]
        vs = lax.dynamic_slice(v_pad, (b, start, 0, 0), (1, MAX_SPAN + Q_BLOCK, H, hd))[0]
        pos = start + qi
        lses, outs = [], []
        for gidx, dist in branches:
            kg = jnp.take(ks, gidx, axis=0).astype(jnp.float32)
            vg = jnp.take(vs, gidx, axis=0).astype(jnp.float32)
            distf = dist.astype(jnp.float32)
            s = jnp.einsum('qhd,qjhd->hqj', qb, kg) - slopes[:, None, None] * distf[None, None, :]
            valid = (pos[:, None] - dist[None, :]) >= 0
            s = jnp.where(valid[None], s, -1e30)
            m = jnp.max(s, axis=-1, keepdims=True)
            p = jnp.exp(s - m)
            z = jnp.sum(p, axis=-1, keepdims=True)
            o = jnp.einsum('hqj,qjhd->qhd', p, vg) / jnp.transpose(z, (1, 0, 2))
            lses.append(jnp.transpose((m + jnp.log(z))[..., 0], (1, 0)))
            outs.append(o)
        wts = jax.nn.softmax(jnp.stack(lses, axis=0), axis=0)
        out = jnp.einsum('gqh,gqhd->qhd', wts, jnp.stack(outs, axis=0))
        return out.astype(q.dtype)

    out = lax.map(block, jnp.arange(B * nblk))
    return out.reshape(B, S, H, hd)


def multiscale_pool(u, w_pool, pool_scale):
    B, S, C = u.shape
    uf = u.astype(jnp.float32)
    cs = jnp.pad(jnp.cumsum(uf, axis=1), ((0, 0), (1, 0), (0, 0)))
    pos1 = jnp.arange(1, S + 1, dtype=jnp.float32)
    outs = []
    for g, w in enumerate(POOL_WINDOWS):
        sl = slice(g * POOL_GROUP, (g + 1) * POOL_GROUP)
        cg = cs[:, :, sl]
        upper = cg[:, 1:]
        lower = jnp.pad(cg, ((0, 0), (w - 1, 0), (0, 0)))[:, :S]
        cnt = jnp.minimum(pos1, float(w))[None, :, None]
        mixed = (upper - lower) / cnt - uf[:, :, sl]
        outs.append(jnp.einsum('bsc,ce->bse', mixed, w_pool[g].astype(jnp.float32)))
    y = jnp.concatenate(outs, axis=-1) * pool_scale.astype(jnp.float32)
    return y.astype(u.dtype)


def peer_ffn(h, w_q, sub_keys, expert_u, expert_v):
    B, S, D = h.shape
    T = B * S
    half = PEER_QDIM // 2
    K = PEER_TOPK
    hc = h.reshape(T // TOKEN_CHUNK, TOKEN_CHUNK, D)

    def chunk(xc):
        C = xc.shape[0]
        q = jnp.einsum('cd,de->ce', xc, w_q).astype(jnp.float32).reshape(C, PEER_HEADS, 2, half)
        s = jnp.einsum('chpk,pnk->chpn', q, sub_keys.astype(jnp.float32))
        sv, si = lax.top_k(s, K)
        cand = sv[:, :, 0, :, None] + sv[:, :, 1, None, :]
        cand_id = si[:, :, 0, :, None] * PEER_NKEYS + si[:, :, 1, None, :]
        cand = cand.reshape(C, PEER_HEADS, K * K)
        cand_id = cand_id.reshape(C, PEER_HEADS, K * K)
        top_v, top_pos = lax.top_k(cand, K)
        eid = jnp.take_along_axis(cand_id, top_pos, axis=-1)
        gate = jax.nn.softmax(top_v, axis=-1)
        u = expert_u[eid]
        act = jax.nn.gelu(jnp.einsum('cd,chkd->chk', xc, u).astype(jnp.float32), approximate=False)
        vv = expert_v[eid]
        y = jnp.einsum('chk,chkd->cd', (gate * act).astype(vv.dtype), vv)
        return y.astype(xc.dtype)

    return lax.map(chunk, hc).reshape(B, S, D)


def setup_inputs(seed: int = 0) -> dict:
    key = jax.random.key(seed)
    ks = jax.random.split(key, 16)
    D = D_MODEL
    proj_out = 3 * ATTN_WIDTH + POOL_WIDTH
    f32 = jnp.float32
    x = jax.random.normal(ks[0], (BATCH, SEQ, D), f32)
    c = jax.random.normal(ks[1], (BATCH, D), f32)
    w_ada = jax.random.normal(ks[2], (DEPTH, D, N_MOD * D), f32) * (0.5 * D ** -0.5)
    b_ada = jax.random.normal(ks[3], (DEPTH, N_MOD * D), f32) * 0.01
    norm1_g = 1.0 + 0.05 * jax.random.normal(ks[4], (DEPTH, D), f32)
    w_in = jax.random.normal(ks[5], (DEPTH, D, proj_out), f32) * D ** -0.5
    pool_w = jax.random.normal(ks[6], (DEPTH, len(POOL_WINDOWS), POOL_GROUP, POOL_GROUP), f32) * POOL_GROUP ** -0.5
    pool_scale = 1.0 + 0.1 * jax.random.normal(ks[7], (DEPTH, POOL_WIDTH), f32)
    w_out = jax.random.normal(ks[8], (DEPTH, MIX_WIDTH, D), f32) * MIX_WIDTH ** -0.5
    norm2_g = 1.0 + 0.05 * jax.random.normal(ks[9], (DEPTH, D), f32)
    peer_wq = jax.random.normal(ks[10], (DEPTH, D, PEER_HEADS * PEER_QDIM), f32) * D ** -0.5
    peer_subkeys = jax.random.normal(ks[11], (DEPTH, 2, PEER_NKEYS, PEER_QDIM // 2), f32) * (PEER_QDIM // 2) ** -0.5
    peer_u = jax.random.normal(ks[12], (DEPTH, PEER_EXPERTS, D), f32) * D ** -0.5
    peer_v = jax.random.normal(ks[13], (DEPTH, PEER_EXPERTS, D), f32) * 0.5
    final_g = 1.0 + 0.05 * jax.random.normal(ks[14], (D,), f32)
    return {"x": x, "c": c, "w_ada": w_ada, "b_ada": b_ada, "norm1_g": norm1_g,
            "w_in": w_in, "pool_w": pool_w, "pool_scale": pool_scale, "w_out": w_out,
            "norm2_g": norm2_g, "peer_wq": peer_wq, "peer_subkeys": peer_subkeys,
            "peer_u": peer_u, "peer_v": peer_v, "final_g": final_g}


def reference(x, c, w_ada, b_ada, norm1_g, w_in, pool_w, pool_scale, w_out,
              norm2_g, peer_wq, peer_subkeys, peer_u, peer_v, final_g):
    B, S, D = x.shape
    A = ATTN_WIDTH
    for l in range(DEPTH):
        mod = jnp.einsum('bd,de->be', jax.nn.silu(c), w_ada[l]) + b_ada[l]
        sh1, sc1, g1, sh2, sc2, g2 = jnp.split(mod[:, None, :], N_MOD, axis=-1)
        h = rmsnorm(x, norm1_g[l]) * (1.0 + sc1) + sh1
        proj = jnp.einsum('bsd,de->bse', h, w_in[l])
        q, k, v, u = jnp.split(proj, [A, 2 * A, 3 * A], axis=-1)
        attn = dilated_attention(q.reshape(B, S, N_HEADS, HEAD_DIM),
                                 k.reshape(B, S, N_HEADS, HEAD_DIM),
                                 v.reshape(B, S, N_HEADS, HEAD_DIM)).reshape(B, S, A)
        pool = multiscale_pool(u, pool_w[l], pool_scale[l])
        mixed = jnp.einsum('bse,ed->bsd', jnp.concatenate([attn, pool], axis=-1), w_out[l])
        x = x + g1 * mixed
        h2 = rmsnorm(x, norm2_g[l]) * (1.0 + sc2) + sh2
        x = x + g2 * peer_ffn(h2, peer_wq[l], peer_subkeys[l], peer_u[l], peer_v[l])
    return rmsnorm(x, final_g)
```

```cpp
#include <hip/hip_runtime.h>
#include <hip/hip_cooperative_groups.h>
#include <cstdio>
#include <cstdint>
namespace cg = cooperative_groups;

#ifndef DEBUG_CHECKS
#define DEBUG_CHECKS 0
#endif
#ifndef N_LAUNCH_MODE
#define N_LAUNCH_MODE 1
#endif

#define LAS __attribute__((address_space(3)))
typedef unsigned short bf16_t;
typedef short bf16x8 __attribute__((ext_vector_type(8)));
typedef short s16x4 __attribute__((ext_vector_type(4)));
typedef float f32x4 __attribute__((ext_vector_type(4)));
typedef float f32x16 __attribute__((ext_vector_type(16)));
typedef unsigned u32x4 __attribute__((ext_vector_type(4)));
typedef unsigned u32x2 __attribute__((ext_vector_type(2)));
typedef _Float16 half2_t __attribute__((ext_vector_type(2)));

constexpr int T_ = 65536, D_ = 1024, S_ = 8192, NB_ = 8, MODW = 6144;
constexpr int NPH = 12;
constexpr size_t WS_CTL = 0;
constexpr size_t WS_PMAX = 4096;
constexpr size_t WS_MOD = 8192;
constexpr size_t WS_WIN = WS_MOD + 196608;
constexpr size_t WS_WOUT = WS_WIN + 4194304;
constexpr size_t WS_WQ = WS_WOUT + 2097152;
constexpr size_t WS_SK = WS_WQ + 4194304;
constexpr size_t WS_U8 = WS_SK + 65536;
constexpr size_t WS_V8 = WS_U8 + 16777216;
constexpr size_t WS_H = WS_V8 + 16777216;
constexpr size_t WS_QKVU = WS_H + 134217728;
constexpr size_t WS_X1 = WS_QKVU + 268435456;
constexpr size_t WS_H8 = WS_X1 + 134217728;
constexpr size_t WS_HSC = WS_H8 + 67108864;
constexpr size_t WS_EID = WS_X1 + 268435456;
constexpr size_t WS_GATE = WS_EID + 16777216;
constexpr size_t WS_PART = WS_QKVU;
constexpr size_t WS_COEF = WS_GATE + 33554432;
constexpr size_t WS_SSQ = WS_COEF + 33554432;
constexpr size_t WS_BAR = WS_SSQ + 2097152;
constexpr size_t WS_END = WS_BAR + 32768;
constexpr int LDS_BYTES = 155648;

struct Params {
    const float *x, *c, *w_ada, *b_ada, *norm1_g, *w_in, *pool_w, *pool_scale, *w_out, *norm2_g, *peer_wq, *peer_sk, *peer_u, *peer_v, *final_g;
    float* out; unsigned char* ws; int ph_lo, ph_hi;
};

__device__ __forceinline__ bf16_t f2bf(float f) { unsigned u = __float_as_uint(f); u += 0x7FFFu + ((u >> 16) & 1u); return (bf16_t)(u >> 16); }
__device__ __forceinline__ float bf2f(bf16_t h) { return __uint_as_float(((unsigned)h) << 16); }
__device__ __forceinline__ unsigned pk2(float lo, float hi) { unsigned r; asm volatile("v_cvt_pk_bf16_f32 %0, %1, %2" : "=v"(r) : "v"(lo), "v"(hi)); return r; }
__device__ __forceinline__ float wave_sum(float v) {
#pragma unroll
    for (int o = 1; o < 64; o <<= 1) v += __shfl_xor(v, o);
    return v;
}
__device__ __forceinline__ float wave_max(float v) {
#pragma unroll
    for (int o = 1; o < 64; o <<= 1) v = fmaxf(v, __shfl_xor(v, o));
    return v;
}
__device__ __forceinline__ float fast_exp2(float x) { return __builtin_amdgcn_exp2f(x); }
namespace pg8 {
#define PG8_LAS __attribute__((address_space(3)))
typedef unsigned short bf16_t;
typedef short bf16x8 __attribute__((ext_vector_type(8)));
typedef float f32x4 __attribute__((ext_vector_type(4)));
typedef unsigned u32x4 __attribute__((ext_vector_type(4)));
constexpr int BM = 256, BK = 64, HALF = 128, HTB = HALF * BK * 2  , STAGE_BYTES = 8 * HTB, NXCD = 8, WGM = 8;

__host__ __device__ __forceinline__ int lds_byte(int r, int c) { const int st = (r >> 4) * 2 + (c >> 5), rr = r & 15, cc = c & 31, ob = rr * 64 + cc * 2; return st * 1024 + (ob ^ (((ob >> 9) & 1) << 5)); }
__host__ __device__ __forceinline__ void stage_rc(int b, int& R, int& C) { const int st = b / 1024, sb = b % 1024, swz = sb ^ (((sb >> 9) & 1) << 5); R = (st >> 1) * 16 + swz / 64; C = (st & 1) * 32 + (swz % 64) / 2; }
__host__ __device__ __forceinline__ int perm32(int rho) { const int n = rho >> 4, i = rho & 15; return 8 * (i >> 2) + 4 * n + (i & 3); }

struct Unit { int pm, pn; };
struct Gemm { const bf16_t* A; const bf16_t* Bt; int M, N, K; };

struct StaticOrder {
    int nM, nN, nwg, G, c;
    __host__ __device__ void init(int M, int N, int G_, int c_) { nM = M / BM; nN = N / BM; nwg = nM * nN; G = G_; c = c_; }
    __host__ __device__ bool next(int i, Unit& u) const {
        const long L = (long)i * G + c; if (L >= nwg) return false;
        int wgid = (int)L; { const int q = nwg / NXCD, r = nwg % NXCD, xcd = wgid % NXCD, off = wgid / NXCD; wgid = (xcd < r ? xcd * (q + 1) : r * (q + 1) + (xcd - r) * q) + off; }
        const int nig = WGM * nN, gid = wgid / nig, fm = gid * WGM, gsz = (nM - fm) < WGM ? (nM - fm) : WGM;
        u.pm = fm + ((wgid % nig) % gsz); u.pn = (wgid % nig) / gsz; return true;
    }
    __device__ __forceinline__ void a_ready(const Unit&) const {}
    __device__ __forceinline__ void done(const Unit&) const {}
};
__device__ __forceinline__ unsigned cvt_pk_bf16(float lo, float hi) { unsigned r; asm volatile("v_cvt_pk_bf16_f32 %0, %1, %2" : "=v"(r) : "v"(lo), "v"(hi)); return r; }
struct EpiBf16 {
    static constexpr bool PERM = true, AFTER_DRAIN = false;
    bf16_t* O; int ldc; int nscaled; float scale;
    __device__ __forceinline__ void operator()(const f32x4 (&acc)[2][2][4][2], const Unit& u, int wr, int wc, int fr, int fq) const {
        const int row0 = u.pm * BM + wr * 64 + fr, col0 = u.pn * BM + wc * 32 + 8 * fq;
        const float sc = (u.pn < nscaled) ? scale : 1.0f;
#pragma unroll
        for (int ai = 0; ai < 2; ++ai)
#pragma unroll
            for (int m = 0; m < 4; ++m) { bf16_t* rowp = O + (size_t)(row0 + ai * HALF + m * 16) * ldc + col0;
#pragma unroll
                for (int bj = 0; bj < 2; ++bj) { const f32x4 v0 = acc[ai][bj][m][0] * sc, v1 = acc[ai][bj][m][1] * sc;
                    u32x4 w; w.x = cvt_pk_bf16(v0[0], v0[1]); w.y = cvt_pk_bf16(v0[2], v0[3]); w.z = cvt_pk_bf16(v1[0], v1[1]); w.w = cvt_pk_bf16(v1[2], v1[3]);
                    *(u32x4*)(rowp + bj * HALF) = w; } }
    }
};
struct EpiResB {
    static constexpr bool PERM = true, AFTER_DRAIN = false;
    const float* X; bf16_t* X1; const float* gate;
    __device__ __forceinline__ void operator()(const f32x4 (&acc)[2][2][4][2], const Unit& u, int wr, int wc, int fr, int fq) const {
        const int row0 = u.pm * BM + wr * 64 + fr, col0 = u.pn * BM + wc * 32 + 8 * fq;
        const float* gp = gate + (size_t)(u.pm >> 5) * 6144 + col0;
        f32x4 gv[2][2];
#pragma unroll
        for (int bj = 0; bj < 2; ++bj)
#pragma unroll
            for (int n = 0; n < 2; ++n) gv[bj][n] = *(const f32x4*)(gp + bj * HALF + 4 * n);
#pragma unroll
        for (int ai = 0; ai < 2; ++ai)
#pragma unroll
            for (int m = 0; m < 4; ++m) { const size_t off = (size_t)(row0 + ai * HALF + m * 16) * 1024 + col0;
#pragma unroll
                for (int bj = 0; bj < 2; ++bj) { const f32x4 x0 = *(const f32x4*)(X + off + bj * HALF), x1 = *(const f32x4*)(X + off + bj * HALF + 4);
                    const f32x4 y0 = x0 + gv[bj][0] * acc[ai][bj][m][0], y1 = x1 + gv[bj][1] * acc[ai][bj][m][1];
                    u32x4 w; w.x = cvt_pk_bf16(y0[0], y0[1]); w.y = cvt_pk_bf16(y0[2], y0[3]); w.z = cvt_pk_bf16(y1[0], y1[1]); w.w = cvt_pk_bf16(y1[2], y1[3]);
                    *(u32x4*)(X1 + off + bj * HALF) = w; } }
    }
};
struct EpiRes {
    static constexpr bool PERM = false, AFTER_DRAIN = false;
    const float* X; float* X1; const float* gate;
    __device__ __forceinline__ void operator()(const f32x4 (&acc)[2][2][4][2], const Unit& u, int wr, int wc, int fr, int fq) const {
        const int row0 = u.pm * BM + wr * 64 + fr, col0 = u.pn * BM + wc * 32 + 4 * fq;
        const float* gp = gate + (size_t)(u.pm >> 5) * 6144 + col0;
        f32x4 gv[2][2];
#pragma unroll
        for (int bj = 0; bj < 2; ++bj)
#pragma unroll
            for (int n = 0; n < 2; ++n) gv[bj][n] = *(const f32x4*)(gp + bj * HALF + n * 16);
#pragma unroll
        for (int ai = 0; ai < 2; ++ai)
#pragma unroll
            for (int m = 0; m < 4; ++m) { const size_t off = (size_t)(row0 + ai * HALF + m * 16) * 1024 + col0;
#pragma unroll
                for (int bj = 0; bj < 2; ++bj)
#pragma unroll
                    for (int n = 0; n < 2; ++n) { const f32x4 xv = *(const f32x4*)(X + off + bj * HALF + n * 16);
                        *(f32x4*)(X1 + off + bj * HALF + n * 16) = xv + gv[bj][n] * acc[ai][bj][m][n]; } }
    }
};
template <class Epi, class Sched>
__device__ __forceinline__ void gemm_phase(PG8_LAS unsigned char* lds, const Gemm g, const Sched& S, const Epi& E, const int tid_flat) {
    const int tid = tid_flat, wid = __builtin_amdgcn_readfirstlane(tid >> 6), lane = tid & 63, wr = wid >> 2, wc = wid & 3, fr = lane & 15, fq = lane >> 4;
    const int K = g.K, nt = K / BK;
    unsigned voffA[2], voffB[2];
#pragma unroll
    for (int i = 0; i < 2; ++i) { int R, C; stage_rc(tid * 16 + i * 8192, R, C); const int Rb = Epi::PERM ? ((R & ~31) + perm32(R & 31)) : R;
        voffA[i] = (unsigned)(R * K + C) * 2u; voffB[i] = (unsigned)(Rb * K + C) * 2u; }
    const size_t kstep = (size_t)(BK * 2);
    const size_t hstep = (size_t)HALF * K * 2;
    const size_t tstep = 2 * hstep;
    const unsigned ldsw = (unsigned)wid * 1024u;
    const int aoff = lds_byte(wr * 64 + fr, fq * 8), boff = lds_byte(wc * 32 + fr, fq * 8);
#define PG8_SA(b, h) (((b) * 2 + (h)) * HTB)
#define PG8_SB(b, h) ((4 + (b) * 2 + (h)) * HTB)
#define PG8_STAGE(bufoff, gbase, voff) do { _Pragma("unroll") for (int _i = 0; _i < 2; ++_i) \
        __builtin_amdgcn_global_load_lds((const unsigned*)((const char*)(gbase) + (voff)[_i]), (PG8_LAS unsigned*)(lds + (bufoff) + ldsw + _i * 8192), 16, 0, 0); } while (0)
#define PG8_LDA(dst, b, h) do { _Pragma("unroll") for (int m = 0; m < 4; ++m) _Pragma("unroll") for (int k = 0; k < 2; ++k) dst[m][k] = *(const PG8_LAS bf16x8*)(lds + PG8_SA(b, h) + aoff + m * 2048 + k * 1024); } while (0)
#define PG8_LDB(dst, b, h) do { _Pragma("unroll") for (int n = 0; n < 2; ++n) _Pragma("unroll") for (int k = 0; k < 2; ++k) dst[n][k] = *(const PG8_LAS bf16x8*)(lds + PG8_SB(b, h) + boff + n * 2048 + k * 1024); } while (0)
#define PG8_MMA(ai, bj, At, Bt) do { __builtin_amdgcn_s_setprio(1); _Pragma("unroll") for (int m = 0; m < 4; ++m) _Pragma("unroll") for (int n = 0; n < 2; ++n) _Pragma("unroll") for (int k = 0; k < 2; ++k) \
        acc[ai][bj][m][n] = __builtin_amdgcn_mfma_f32_16x16x32_bf16(Bt[n][k], At[m][k], acc[ai][bj][m][n], 0, 0, 0); __builtin_amdgcn_s_setprio(0); } while (0)
#define PG8_WAIT_V(n) asm volatile("s_waitcnt vmcnt(" #n ")" ::: "memory")
#define PG8_WAIT_L(n) asm volatile("s_waitcnt lgkmcnt(" #n ")" ::: "memory")
#define PG8_BAR __builtin_amdgcn_s_barrier()
#define PG8_SCHED __builtin_amdgcn_sched_barrier(0)
    Unit cur, nxt; int ui = 0;
    if (!S.next(0, cur)) return;
    f32x4 acc[2][2][4][2];
#pragma unroll
    for (int a = 0; a < 2; ++a)
#pragma unroll
        for (int b = 0; b < 2; ++b)
#pragma unroll
            for (int m = 0; m < 4; ++m)
#pragma unroll
                for (int n = 0; n < 2; ++n) acc[a][b][m][n] = (f32x4){0.f, 0.f, 0.f, 0.f};
    bf16x8 At[4][2], B0[2][2], B1[2][2];
    const char* cA = (const char*)g.A + (size_t)cur.pm * tstep; const char* cB = (const char*)g.Bt + (size_t)cur.pn * tstep;
    S.a_ready(cur);
    PG8_STAGE(PG8_SB(0, 0), cB, voffB); PG8_STAGE(PG8_SA(0, 0), cA, voffA); PG8_STAGE(PG8_SB(0, 1), cB + hstep, voffB); PG8_STAGE(PG8_SA(0, 1), cA + hstep, voffA);
    if (wr == 1) PG8_BAR;
    PG8_WAIT_V(4); PG8_BAR;
    PG8_STAGE(PG8_SB(1, 0), cB + kstep, voffB); PG8_STAGE(PG8_SA(1, 0), cA + kstep, voffA); PG8_STAGE(PG8_SB(1, 1), cB + hstep + kstep, voffB);
    PG8_WAIT_V(6); PG8_BAR;
    for (;;) {
        const bool has_next = S.next(ui + 1, nxt);
        const char* nA = has_next ? (const char*)g.A + (size_t)nxt.pm * tstep : cA; const char* nB = has_next ? (const char*)g.Bt + (size_t)nxt.pn * tstep : cB;
        for (int t = 0; t < nt; t += 2) {
            const bool last = (t == nt - 2);
            const char* a1 = cA + (size_t)(t + 1) * kstep;
            const char* a2 = last ? nA : cA + (size_t)(t + 2) * kstep; const char* b2 = last ? nB : cB + (size_t)(t + 2) * kstep;
            const char* a3 = a2 + kstep; const char* b3 = b2 + kstep;
            if (last && has_next) S.a_ready(nxt);
            PG8_LDB(B0, 0, 0); PG8_SCHED; PG8_LDA(At, 0, 0); PG8_STAGE(PG8_SA(1, 1), a1 + hstep, voffA);
            PG8_WAIT_L(8); PG8_BAR; PG8_WAIT_L(0); PG8_MMA(0, 0, At, B0); PG8_BAR; PG8_SCHED;
            PG8_LDB(B1, 0, 1); PG8_STAGE(PG8_SB(0, 0), b2, voffB);
            PG8_BAR; PG8_WAIT_L(0); PG8_MMA(0, 1, At, B1); PG8_BAR;
            PG8_LDA(At, 0, 1); PG8_STAGE(PG8_SA(0, 0), a2, voffA);
            PG8_BAR; PG8_WAIT_L(0); PG8_MMA(1, 0, At, B0); PG8_BAR; PG8_SCHED;
            PG8_STAGE(PG8_SB(0, 1), b2 + hstep, voffB);
            PG8_WAIT_V(6); PG8_BAR; PG8_MMA(1, 1, At, B1); PG8_BAR;
            PG8_LDB(B0, 1, 0); PG8_SCHED; PG8_LDA(At, 1, 0); PG8_STAGE(PG8_SA(0, 1), a2 + hstep, voffA);
            PG8_WAIT_L(8); PG8_BAR; PG8_WAIT_L(0); PG8_MMA(0, 0, At, B0); PG8_BAR; PG8_SCHED;
            PG8_LDB(B1, 1, 1); PG8_STAGE(PG8_SB(1, 0), b3, voffB);
            PG8_BAR; PG8_WAIT_L(0); PG8_MMA(0, 1, At, B1); PG8_BAR;
            PG8_LDA(At, 1, 1); PG8_STAGE(PG8_SA(1, 0), a3, voffA);
            PG8_BAR; PG8_WAIT_L(0); PG8_MMA(1, 0, At, B0); PG8_BAR; PG8_SCHED;
            PG8_STAGE(PG8_SB(1, 1), b3 + hstep, voffB);
            PG8_WAIT_V(6); PG8_BAR; PG8_MMA(1, 1, At, B1); PG8_BAR;
        }
        if constexpr (!Epi::AFTER_DRAIN) { E(acc, cur, wr, wc, fr, fq); S.done(cur); }
        if (!has_next) break;
#pragma unroll
        for (int a = 0; a < 2; ++a)
#pragma unroll
            for (int b = 0; b < 2; ++b)
#pragma unroll
                for (int m = 0; m < 4; ++m)
#pragma unroll
                    for (int n = 0; n < 2; ++n) acc[a][b][m][n] = (f32x4){0.f, 0.f, 0.f, 0.f};
        cur = nxt; cA = nA; cB = nB; ++ui;
    }
    PG8_WAIT_V(0);
    if (wr == 0) PG8_BAR;
    PG8_BAR;
    if constexpr (Epi::AFTER_DRAIN) { E.fused(acc, cur, wr, wc, fr, fq, lds, wid, lane); S.done(cur); }
#undef PG8_SA
#undef PG8_SB
#undef PG8_STAGE
#undef PG8_LDA
#undef PG8_LDB
#undef PG8_MMA
#undef PG8_WAIT_V
#undef PG8_WAIT_L
#undef PG8_BAR
#undef PG8_SCHED
}
}
__device__ __forceinline__ int lane_id_() { return (int)__builtin_amdgcn_mbcnt_hi(~0u, __builtin_amdgcn_mbcnt_lo(~0u, 0u)); }

constexpr int I_MOD = 96, I_TIN = 16 * 24, I_TOUT = 16 * 16, I_TQ = 16 * 32, I_FOLD = 64, I_SK = 1, I_U = 512, I_V = 512;
constexpr int I_TOTAL = I_MOD + I_TIN + I_TOUT + I_TQ + I_FOLD + I_SK + I_U + I_V;

__device__ __forceinline__ void p0_mod_item(const Params& p, LAS unsigned char* lds, int item, int tid) {
    LAS float* sc = (LAS float*)lds;
    LAS float* red = (LAS float*)(lds + 32768);
    for (int i = tid; i < 8192; i += 512) { const float v = p.c[i]; sc[i] = v / (1.0f + __expf(-v)); }
    __syncthreads();
    const int col = tid & 63, kg = tid >> 6;
    float acc[8];
#pragma unroll
    for (int b = 0; b < 8; ++b) acc[b] = 0.f;
    const float* w = p.w_ada + (size_t)(kg * 128) * MODW + item * 64 + col;
#pragma unroll 8
    for (int k = 0; k < 128; ++k) { const float wv = w[(size_t)k * MODW];
#pragma unroll
        for (int b = 0; b < 8; ++b) acc[b] += sc[b * 1024 + kg * 128 + k] * wv; }
#pragma unroll
    for (int b = 0; b < 8; ++b) red[(kg * 8 + b) * 64 + col] = acc[b];
    __syncthreads();
    { const int b = tid >> 6; float s = 0.f;
#pragma unroll
      for (int k2 = 0; k2 < 8; ++k2) s += red[(k2 * 8 + b) * 64 + col];
      float* mod = (float*)(p.ws + WS_MOD);
      mod[b * MODW + item * 64 + col] = s + p.b_ada[item * 64 + col]; }
    __syncthreads();
}
__device__ __forceinline__ void p0_tr_item(const float* W, int N, bf16_t* WT, int K, int row_off, int k0, int n0, LAS unsigned char* lds, int tid) {
    LAS float* tile = (LAS float*)lds;
    { const int kk = tid >> 4, n4 = (tid & 15) * 4;
#pragma unroll
      for (int hf = 0; hf < 2; ++hf) { const int k = kk + 32 * hf; const f32x4 v = *(const f32x4*)(W + (size_t)(k0 + k) * N + n0 + n4);
          tile[k * 65 + n4 + 0] = v[0]; tile[k * 65 + n4 + 1] = v[1]; tile[k * 65 + n4 + 2] = v[2]; tile[k * 65 + n4 + 3] = v[3]; } }
    __syncthreads();
    { const int n = tid >> 3, c = tid & 7; float v[8];
#pragma unroll
      for (int j = 0; j < 8; ++j) v[j] = tile[(8 * c + j) * 65 + n];
      u32x4 o; o.x = pk2(v[0], v[1]); o.y = pk2(v[2], v[3]); o.z = pk2(v[4], v[5]); o.w = pk2(v[6], v[7]);
      *(u32x4*)(WT + (size_t)(row_off + n0 + n) * K + k0 + 8 * c) = o; }
    __syncthreads();
}
__device__ __forceinline__ void p0_fold_item(const Params& p, LAS unsigned char* lds, int item, int tid) {
    const int g = item >> 4, k0 = (item & 15) * 64;
    LAS float* Wn = (LAS float*)lds;
    LAS float* Pw = Wn + 64 * 128;
#pragma unroll
    for (int i = 0; i < 4; ++i) { const int idx = tid * 4 + 2048 * i, row = idx >> 7, col = idx & 127;
        const f32x4 v = *(const f32x4*)(p.w_in + (size_t)(k0 + row) * 2048 + 1536 + g * 128 + col);
        *(LAS f32x4*)(Wn + idx) = v; }
#pragma unroll
    for (int i = 0; i < 8; ++i) { const int idx = tid * 4 + 2048 * i;
        *(LAS f32x4*)(Pw + idx) = *(const f32x4*)(p.pool_w + (size_t)g * 16384 + idx); }
    __syncthreads();
    const int e = tid & 127, kq = tid >> 7;
    float acc[16];
#pragma unroll
    for (int kk = 0; kk < 16; ++kk) acc[kk] = 0.f;
    for (int c = 0; c < 128; ++c) { const float pv = Pw[c * 128 + e];
#pragma unroll
        for (int kk = 0; kk < 16; ++kk) acc[kk] += Wn[(kq * 16 + kk) * 128 + c] * pv; }
    const float scl = p.pool_scale[g * 128 + e];
    bf16_t* WT = (bf16_t*)(p.ws + WS_WIN) + (size_t)(1536 + g * 128 + e) * 1024 + k0 + kq * 16;
    u32x4 o0, o1;
    o0.x = pk2(acc[0] * scl, acc[1] * scl); o0.y = pk2(acc[2] * scl, acc[3] * scl); o0.z = pk2(acc[4] * scl, acc[5] * scl); o0.w = pk2(acc[6] * scl, acc[7] * scl);
    o1.x = pk2(acc[8] * scl, acc[9] * scl); o1.y = pk2(acc[10] * scl, acc[11] * scl); o1.z = pk2(acc[12] * scl, acc[13] * scl); o1.w = pk2(acc[14] * scl, acc[15] * scl);
    *(u32x4*)(WT) = o0; *(u32x4*)(WT + 8) = o1;
    __syncthreads();
}
__device__ __forceinline__ unsigned pkh2(float lo, float hi) { half2_t h; h.x = (_Float16)lo; h.y = (_Float16)hi; return __builtin_bit_cast(unsigned, h); }
template <bool HALFP> __device__ __forceinline__ void p0_cvt_item(const float* src, unsigned short* dst, int item, int tid) {
#pragma unroll 4
    for (int it = 0; it < 8; ++it) { const size_t idx = (size_t)item * 32768 + (size_t)(it * 512 + tid) * 8;
        const f32x4 a = *(const f32x4*)(src + idx), b = *(const f32x4*)(src + idx + 4);
        u32x4 o;
        if (HALFP) { o.x = pkh2(a[0], a[1]); o.y = pkh2(a[2], a[3]); o.z = pkh2(b[0], b[1]); o.w = pkh2(b[2], b[3]); }
        else { o.x = pk2(a[0], a[1]); o.y = pk2(a[2], a[3]); o.z = pk2(b[0], b[1]); o.w = pk2(b[2], b[3]); }
        *(u32x4*)(dst + idx) = o; }
}
__device__ __forceinline__ void p0_max_item(const float* tab, float* pmax, int item, LAS unsigned char* lds, int tid) {
    const float* src = tab + (size_t)(item & 511) * 32768;
    const bool sq = true;
    float m = 0.f;
#pragma unroll 4
    for (int it = 0; it < 16; ++it) { const f32x4 a = *(const f32x4*)(src + (size_t)(it * 512 + tid) * 4);
        if (sq) m += (a[0] * a[0] + a[1] * a[1]) + (a[2] * a[2] + a[3] * a[3]);
        else m = fmaxf(fmaxf(m, fmaxf(fabsf(a[0]), fabsf(a[1]))), fmaxf(fabsf(a[2]), fabsf(a[3]))); }
    m = sq ? wave_sum(m) : wave_max(m);
    LAS float* red = (LAS float*)lds;
    if ((tid & 63) == 0) red[tid >> 6] = m;
    __syncthreads();
    if (tid == 0) { float mm = red[0];
#pragma unroll
        for (int w = 1; w < 8; ++w) mm = sq ? (mm + red[w]) : fmaxf(mm, red[w]);
        pmax[item] = mm; }
    __syncthreads();
}
__device__ __forceinline__ void phase_prep(const Params& p, LAS unsigned char* lds, int tid) {
    for (int it = blockIdx.x; it < I_TOTAL; it += gridDim.x) {
        int r = it;
        if (r < I_MOD) { p0_mod_item(p, lds, r, tid); continue; } r -= I_MOD;
        if (r < I_TIN) { p0_tr_item(p.w_in, 2048, (bf16_t*)(p.ws + WS_WIN), 1024, 0, (r / 24) * 64, (r % 24) * 64, lds, tid); continue; } r -= I_TIN;
        if (r < I_TOUT) { p0_tr_item(p.w_out, 1024, (bf16_t*)(p.ws + WS_WOUT), 1024, 0, (r / 16) * 64, (r % 16) * 64, lds, tid); continue; } r -= I_TOUT;
        if (r < I_TQ) { p0_tr_item(p.peer_wq, 2048, (bf16_t*)(p.ws + WS_WQ), 1024, 0, (r / 32) * 64, (r % 32) * 64, lds, tid); continue; } r -= I_TQ;
        if (r < I_FOLD) { p0_fold_item(p, lds, r, tid); continue; } r -= I_FOLD;
        if (r < I_SK) { p0_cvt_item<false>(p.peer_sk, (unsigned short*)(p.ws + WS_SK), 0, tid); continue; } r -= I_SK;
        p0_max_item(r < I_U ? p.peer_u : p.peer_v, (float*)(p.ws + WS_PMAX), r, lds, tid);
    }
}

__device__ __forceinline__ void phase_norm(const float* X, const bf16_t* MIXED, const float* gv, const float* mod, int sh_off, int sc_off, bf16_t* H, unsigned char* H8, float* HSC, int gw, int nw, int lane, const bf16_t* XB = nullptr) {
    for (int chunk = gw; chunk < T_ / 32; chunk += nw) {
        const int row0 = chunk * 32, b = row0 >> 13;
        f32x4 gm[4], sh[4], g1[4];
#pragma unroll
        for (int j = 0; j < 4; ++j) { const int c = lane * 4 + 256 * j;
            const f32x4 g4 = *(const f32x4*)(gv + c), s4 = *(const f32x4*)(mod + (size_t)b * MODW + sc_off + c);
            gm[j] = g4 * (s4 + 1.0f); sh[j] = *(const f32x4*)(mod + (size_t)b * MODW + sh_off + c);
            g1[j] = MIXED ? *(const f32x4*)(mod + (size_t)b * MODW + 2048 + c) : (f32x4){0.f, 0.f, 0.f, 0.f}; }
        float gmax = 0.f, smax = 0.f;
        if (H8) {
#pragma unroll
            for (int j = 0; j < 4; ++j)
#pragma unroll
                for (int z = 0; z < 4; ++z) { gmax = fmaxf(gmax, fabsf(gm[j][z])); smax = fmaxf(smax, fabsf(sh[j][z])); }
            gmax = wave_max(gmax); smax = wave_max(smax); }
        const float isc8 = __uint_as_float(0x7f000000u - (__float_as_uint(440.0f / fmaxf(32.0f * gmax + smax, 1e-20f)) & 0x7f800000u));
#pragma unroll 4
        for (int r = 0; r < 32; ++r) {
            const float* xr = X + (size_t)(row0 + r) * 1024 + lane * 4;
            f32x4 v[4]; float ss = 0.f;
#pragma unroll
            for (int j = 0; j < 4; ++j) {
                if (XB) { const u32x2 xw = *(const u32x2*)(XB + (size_t)(row0 + r) * 1024 + lane * 4 + 256 * j);
                    v[j] = (f32x4){__uint_as_float(xw.x << 16), __uint_as_float(xw.x & 0xffff0000u), __uint_as_float(xw.y << 16), __uint_as_float(xw.y & 0xffff0000u)}; }
                else v[j] = *(const f32x4*)(xr + 256 * j);
                if (MIXED) { const u32x2 mw = *(const u32x2*)(MIXED + (size_t)(row0 + r) * 1024 + lane * 4 + 256 * j);
                    v[j] += g1[j] * (f32x4){__uint_as_float(mw.x << 16), __uint_as_float(mw.x & 0xffff0000u), __uint_as_float(mw.y << 16), __uint_as_float(mw.y & 0xffff0000u)}; }
                ss += (v[j][0] * v[j][0] + v[j][1] * v[j][1]) + (v[j][2] * v[j][2] + v[j][3] * v[j][3]); }
            ss = wave_sum(ss);
            const float rstd = 1.0f / sqrtf(ss * (1.0f / 1024.0f) + 1e-6f);
            bf16_t* hr = H + (size_t)(row0 + r) * 1024 + lane * 4;
            f32x4 o[4];
#pragma unroll
            for (int j = 0; j < 4; ++j) { o[j] = v[j] * rstd * gm[j] + sh[j];
                u32x2 w; w.x = pk2(o[j][0], o[j][1]); w.y = pk2(o[j][2], o[j][3]); *(u32x2*)(hr + 256 * j) = w; }
            if (H8 && lane == 0) HSC[row0 + r] = isc8;
        }
    }
}

__device__ __forceinline__ void phase_tables_fp8(const Params& p, LAS unsigned char* lds, int tid) {
    const float* pmax = (const float*)(p.ws + WS_PMAX);
    float mu = wave_sum(pmax[tid]), mv = wave_sum(pmax[512 + tid]);
    LAS float* red = (LAS float*)lds;
    if ((tid & 63) == 0) { red[tid >> 6] = mu; red[8 + (tid >> 6)] = mv; }
    __syncthreads();
    mu = red[0]; mv = red[8];
#pragma unroll
    for (int w = 1; w < 8; ++w) { mu += red[w]; mv += red[8 + w]; }
    const float su = 6.0f / (3.0f * fmaxf(sqrtf(mu * (1.0f / 16777216.0f)), 1e-30f)), sv = 6.0f / (3.0f * fmaxf(sqrtf(mv * (1.0f / 16777216.0f)), 1e-30f));
    if (blockIdx.x == 0 && tid == 0) { float* sc = (float*)(p.ws + WS_CTL) + 64; sc[0] = 1.0f / su; sc[1] = 1.0f / sv; }
    __syncthreads();
#pragma unroll 1
    for (int tb = 0; tb < 2; ++tb) {
        const float* src = tb ? p.peer_v : p.peer_u; unsigned char* dstbase = p.ws + (tb ? WS_V8 : WS_U8); const float sc = tb ? sv : su;
        for (size_t gi = ((size_t)blockIdx.x * 512 + tid) * 32; gi < (size_t)16384 * 1024; gi += (size_t)gridDim.x * 512 * 32) {
            u32x4 o;
#pragma unroll
            for (int q = 0; q < 4; ++q) { unsigned w = 0u;
#pragma unroll
                for (int hq = 0; hq < 2; ++hq) { const f32x4 a = *(const f32x4*)(src + gi + 8 * q + 4 * hq) * sc;
#pragma unroll
                    for (int z = 0; z < 4; ++z) { const float ax = fabsf(a[z]);
                        const unsigned code = (unsigned)(ax > 0.25f) + (unsigned)(ax > 0.75f) + (unsigned)(ax > 1.25f) + (unsigned)(ax > 1.75f) + (unsigned)(ax > 2.5f) + (unsigned)(ax > 3.5f) + (unsigned)(ax > 5.0f) + (a[z] < 0.f ? 8u : 0u);
                        w |= code << (4 * (4 * hq + z)); } }
                o[q] = w; }
            const size_t e = gi >> 10, col = gi & 1023;
            *(u32x4*)(dstbase + (((col >> 8) * 16384 + e) << 7) + ((col & 255) >> 1)) = o; }
    }
}

__device__ __forceinline__ bf16x8 mk_bf16x8(const u32x4 v) { return __builtin_bit_cast(bf16x8, v); }
struct AttnTask { int d, r, c, kt0, qloc; float c1; };
__device__ __forceinline__ AttnTask attn_task(int n, int wave, int p0, int i, float slope) {
    AttnTask t; const int br = n >> 1, tk = n & 1, tprl = 4 - 2 * br; t.d = 1 << (2 * br);
    const int tau = wave + 8 * tk; t.r = tau >> tprl; t.c = tau & ((1 << tprl) - 1);
    t.qloc = t.r + t.d * (32 * t.c + i);
    const int first = 4 - t.c - p0 / (32 * t.d);
    t.kt0 = first > 0 ? first : 0;
    t.c1 = slope * (float)t.d * 1.4426950408889634f;
    return t;
}
struct AttnTile { u32x4 kr[4]; u32x4 vr[4]; };
__device__ __forceinline__ void attn_load_tile(AttnTile& T, const bf16_t* QKV, size_t tok0, int p0, const AttnTask& t, int kt, int hh, int i, int h, int lane) {
    const int kbase = p0 + t.r + t.d * 32 * (t.c - 4 + kt);
#pragma unroll
    for (int n = 0; n < 4; ++n) { const bf16_t* rp = QKV + (tok0 + kbase + t.d * (8 * n + (lane >> 3))) * 2048 + 64 * hh + 8 * (lane & 7);
        T.kr[n] = *(const u32x4*)(rp + 512); T.vr[n] = *(const u32x4*)(rp + 1024); }
}
#ifndef PROBE_ATT
#define PROBE_ATT 0
#endif
#ifndef REP_MASK
#define REP_MASK 0
#endif
#ifndef REPS
#define REPS(k) ((((REP_MASK) >> (k)) & 1) ? 2 : 1)
#endif
__device__ __forceinline__ void attn_item(const Params& p, LAS unsigned char* lds, int item, int tid, int wave, int lane, bool probe) {
    const bf16_t* QKV = (const bf16_t*)(p.ws + WS_QKVU);
    bf16_t* MIX = (bf16_t*)(p.ws + (probe ? WS_X1 : WS_H));
    const int blk = item & 15, hh = (item >> 4) & 7, b = item >> 7;
    const int p0 = blk * 512; const size_t tok0 = (size_t)b * 8192;
    LAS float* Ol = (LAS float*)lds;
    LAS float* Ml = (LAS float*)(lds + 131072);
    LAS float* Ll = Ml + 512;
    LAS unsigned char* vst = lds + 131072 + 4096 + wave * 2048;
    const int i = lane & 31, h = lane >> 5;
    const float LOG2E = 1.4426950408889634f;
    const float slope = __builtin_amdgcn_exp2f(-(float)(hh + 1));
    AttnTask T = attn_task(0, wave, p0, i, slope);
    bf16x8 qf[4];
    { const bf16_t* qp = QKV + (tok0 + p0 + T.qloc) * 2048 + 64 * hh + 8 * h;
#pragma unroll
      for (int s = 0; s < 4; ++s) qf[s] = *(const bf16x8*)(qp + 16 * s); }
    AttnTile cur; attn_load_tile(cur, QKV, tok0, p0, T, T.kt0, hh, i, h, lane);
#pragma unroll 1
    for (int n = 0; n < 6; ++n) {
        const int br = n >> 1;
        const AttnTask Tn = attn_task(n < 5 ? n + 1 : n, wave, p0, i, slope);
        bf16x8 qn[4];
#pragma unroll
        for (int s = 0; s < 4; ++s) qn[s] = qf[s];
        float m = -1e30f, l = 0.f;
        f32x16 o0, o1;
#pragma unroll
        for (int e = 0; e < 16; ++e) { o0[e] = 0.f; o1[e] = 0.f; }
        const float c1 = T.c1;
#pragma unroll 1
        for (int kt = T.kt0; kt < 5; ++kt) {
            AttnTile nxt;
            if (kt < 4) attn_load_tile(nxt, QKV, tok0, p0, T, (PROBE_ATT == 1 && probe) ? 4 : kt + 1, hh, i, h, lane);
            else { attn_load_tile(nxt, QKV, tok0, p0, Tn, (PROBE_ATT == 1 && probe) ? 4 : Tn.kt0, hh, i, h, lane);
                   const bf16_t* qp = QKV + (tok0 + p0 + Tn.qloc) * 2048 + 64 * hh + 8 * h;
#pragma unroll
                   for (int s = 0; s < 4; ++s) qn[s] = *(const bf16x8*)(qp + 16 * s); }
            const float base = -c1 * (float)(128 - 32 * kt + i - 4 * h);
            f32x16 sa;
#pragma unroll
            for (int rho = 0; rho < 16; ++rho) sa[rho] = base + c1 * (float)((rho & 3) + 8 * (rho >> 2));
            bf16x8 kf[4];
            { const int r8 = lane >> 3, c = lane & 7;
              const unsigned wofs = (unsigned)(r8 * 64) + 16u * (unsigned)((c & 3) ^ (r8 >> 2)), rofs = (unsigned)(i * 64), rsw = (unsigned)((i >> 2) & 3);
#pragma unroll
              for (int hf = 0; hf < 2; ++hf) {
                  if ((c >> 2) == hf) {
#pragma unroll
                      for (int n = 0; n < 4; ++n) *(LAS u32x4*)(vst + (wofs ^ (unsigned)(16 * ((2 * n) & 3))) + 512 * n) = cur.kr[n]; }
                  __builtin_amdgcn_fence(__ATOMIC_ACQ_REL, "wavefront"); __builtin_amdgcn_wave_barrier(); asm volatile("" ::: "memory");
                  kf[2 * hf + 0] = mk_bf16x8(*(const LAS u32x4*)(vst + rofs + 16u * ((unsigned)(0 + h) ^ rsw)));
                  kf[2 * hf + 1] = mk_bf16x8(*(const LAS u32x4*)(vst + rofs + 16u * ((unsigned)(2 + h) ^ rsw))); } }
#pragma unroll
            for (int s = 0; s < 4; ++s) sa = __builtin_amdgcn_mfma_f32_32x32x16_bf16(kf[s], qf[s], sa, 0, 0, 0);
            float t[16]; float mx = -INFINITY;
            if (kt == 0) {
#pragma unroll
                for (int rho = 0; rho < 16; ++rho) { const int jj = (rho & 3) + 8 * (rho >> 2) + 4 * h;
                    t[rho] = (jj < i) ? -INFINITY : sa[rho]; mx = fmaxf(mx, t[rho]); }
            } else if (kt == 4) {
#pragma unroll
                for (int rho = 0; rho < 16; ++rho) { const int jj = (rho & 3) + 8 * (rho >> 2) + 4 * h;
                    t[rho] = (jj > i) ? -INFINITY : sa[rho]; mx = fmaxf(mx, t[rho]); }
            } else {
#pragma unroll
                for (int rho = 0; rho < 16; ++rho) { t[rho] = sa[rho]; mx = fmaxf(mx, t[rho]); }
            }
            mx = fmaxf(mx, __shfl_xor(mx, 32));
            if (!__all(mx <= m)) {
                const float mn = fmaxf(m, mx), alpha = fast_exp2(m - mn);
                l *= alpha; m = mn;
#pragma unroll
                for (int e = 0; e < 16; ++e) { o0[e] *= alpha; o1[e] *= alpha; }
            }
            float ls = 0.f;
#pragma unroll
            for (int rho = 0; rho < 16; ++rho) { t[rho] = fast_exp2(t[rho] - m); ls += t[rho]; }
            l += ls;
            bf16x8 pb[2];
#pragma unroll
            for (int s2 = 0; s2 < 2; ++s2) { u32x4 w; w.x = pk2(t[8 * s2 + 0], t[8 * s2 + 1]); w.y = pk2(t[8 * s2 + 2], t[8 * s2 + 3]); w.z = pk2(t[8 * s2 + 4], t[8 * s2 + 5]); w.w = pk2(t[8 * s2 + 6], t[8 * s2 + 7]); pb[s2] = mk_bf16x8(w); }
#pragma unroll
            for (int s2 = 0; s2 < 2; ++s2) {
                *(LAS u32x4*)(vst + (0 + (lane >> 3)) * 128 + (lane & 7) * 16) = cur.vr[2 * s2 + 0];
                *(LAS u32x4*)(vst + (8 + (lane >> 3)) * 128 + (lane & 7) * 16) = cur.vr[2 * s2 + 1];
                const int q4 = (lane & 15) >> 2, p4 = lane & 3, g1 = (lane >> 4) & 1;
                LAS unsigned char* rb = vst + (4 * h + q4) * 128 + (16 * g1 + 4 * p4) * 2;
                const s16x4 a0 = __builtin_amdgcn_ds_read_tr16_b64_v4i16((LAS s16x4*)(rb));
                const s16x4 a1 = __builtin_amdgcn_ds_read_tr16_b64_v4i16((LAS s16x4*)(rb + 8 * 128));
                const s16x4 b0 = __builtin_amdgcn_ds_read_tr16_b64_v4i16((LAS s16x4*)(rb + 64));
                const s16x4 b1 = __builtin_amdgcn_ds_read_tr16_b64_v4i16((LAS s16x4*)(rb + 8 * 128 + 64));
                bf16x8 vf0, vf1;
                vf0[0] = a0[0]; vf0[1] = a0[1]; vf0[2] = a0[2]; vf0[3] = a0[3]; vf0[4] = a1[0]; vf0[5] = a1[1]; vf0[6] = a1[2]; vf0[7] = a1[3];
                vf1[0] = b0[0]; vf1[1] = b0[1]; vf1[2] = b0[2]; vf1[3] = b0[3]; vf1[4] = b1[0]; vf1[5] = b1[1]; vf1[6] = b1[2]; vf1[7] = b1[3];
                o0 = __builtin_amdgcn_mfma_f32_32x32x16_bf16(vf0, pb[s2], o0, 0, 0, 0);
                o1 = __builtin_amdgcn_mfma_f32_32x32x16_bf16(vf1, pb[s2], o1, 0, 0, 0);
            }
            cur = nxt;
        }
        l += __shfl_xor(l, 32);
        const int qloc = T.qloc;
        LAS float* orow = Ol + qloc * 64; const int sw = qloc & 15;
        if (br == 0) {
#pragma unroll
            for (int g4 = 0; g4 < 4; ++g4) { const int ch0 = 2 * g4 + h, ch1 = 8 + 2 * g4 + h;
                *(LAS f32x4*)(orow + ((ch0 ^ sw) * 4)) = (f32x4){o0[4 * g4], o0[4 * g4 + 1], o0[4 * g4 + 2], o0[4 * g4 + 3]};
                *(LAS f32x4*)(orow + ((ch1 ^ sw) * 4)) = (f32x4){o1[4 * g4], o1[4 * g4 + 1], o1[4 * g4 + 2], o1[4 * g4 + 3]}; }
            if (h == 0) { Ml[qloc] = m; Ll[qloc] = l; }
        } else {
            const float m0 = Ml[qloc], l0 = Ll[qloc];
            const float mn = fmaxf(m0, m), a0 = fast_exp2(m0 - mn), a1 = fast_exp2(m - mn);
#pragma unroll
            for (int g4 = 0; g4 < 4; ++g4) { const int ch0 = 2 * g4 + h, ch1 = 8 + 2 * g4 + h;
                LAS f32x4* q0 = (LAS f32x4*)(orow + ((ch0 ^ sw) * 4)); LAS f32x4* q1 = (LAS f32x4*)(orow + ((ch1 ^ sw) * 4));
                const f32x4 x0 = *q0, x1 = *q1;
                *q0 = x0 * a0 + (f32x4){o0[4 * g4], o0[4 * g4 + 1], o0[4 * g4 + 2], o0[4 * g4 + 3]} * a1;
                *q1 = x1 * a0 + (f32x4){o1[4 * g4], o1[4 * g4 + 1], o1[4 * g4 + 2], o1[4 * g4 + 3]} * a1; }
            if (h == 0) { Ml[qloc] = mn; Ll[qloc] = l0 * a0 + l * a1; }
        }
        if (n & 1) __syncthreads();
        T = Tn;
#pragma unroll
        for (int s = 0; s < 4; ++s) qf[s] = qn[s];
    }
#pragma unroll 2
    for (int it = 0; it < 8; ++it) { const int idx = it * 512 + tid, qi = idx >> 3, oc = idx & 7;
        const float inv = 1.0f / Ll[qi]; const int sw = qi & 15;
        const f32x4 a = *(LAS f32x4*)(Ol + qi * 64 + (((2 * oc) ^ sw) * 4)), bq = *(LAS f32x4*)(Ol + qi * 64 + (((2 * oc + 1) ^ sw) * 4));
        u32x4 w; w.x = pk2(a[0] * inv, a[1] * inv); w.y = pk2(a[2] * inv, a[3] * inv); w.z = pk2(bq[0] * inv, bq[1] * inv); w.w = pk2(bq[2] * inv, bq[3] * inv);
        *(u32x4*)(MIX + (tok0 + p0 + qi) * 1024 + 64 * hh + 8 * oc) = w; }
    __syncthreads();
}
__device__ __forceinline__ void pool_wave(const Params& p, int task, int lane) {
    const bf16_t* U = (const bf16_t*)(p.ws + WS_QKVU) + 1536 + 8 * lane;
    bf16_t* MIX = (bf16_t*)(p.ws + WS_H) + 512 + 8 * lane;
    const int t0 = task * 8, pos0 = t0 & 8191;
    const int g = lane >> 4, w = 2 << g;
    u32x4 rw[23];
#pragma unroll
    for (int j = 0; j < 23; ++j) { rw[j] = (u32x4){0u, 0u, 0u, 0u}; if (pos0 - 15 + j >= 0) rw[j] = *(const u32x4*)(U + (size_t)(t0 - 15 + j) * 2048); }
    float sum[8];
#pragma unroll
    for (int ch = 0; ch < 8; ++ch) sum[ch] = 0.f;
#pragma unroll
    for (int j = 0; j < 15; ++j) { const bool in = (j >= 16 - w);
#pragma unroll
        for (int q = 0; q < 4; ++q) { const unsigned v = in ? rw[j][q] : 0u; sum[2 * q] += __uint_as_float(v << 16); sum[2 * q + 1] += __uint_as_float(v & 0xffff0000u); } }
#pragma unroll
    for (int k = 0; k < 8; ++k) {
        float cur[8], o[8];
#pragma unroll
        for (int q = 0; q < 4; ++q) { const unsigned v = rw[15 + k][q]; cur[2 * q] = __uint_as_float(v << 16); cur[2 * q + 1] = __uint_as_float(v & 0xffff0000u); }
        const int posk = pos0 + k; const float inv = 1.0f / (float)((posk + 1 < w) ? (posk + 1) : w);
#pragma unroll
        for (int ch = 0; ch < 8; ++ch) { sum[ch] += cur[ch]; o[ch] = sum[ch] * inv - cur[ch]; }
        u32x4 w4; w4.x = pk2(o[0], o[1]); w4.y = pk2(o[2], o[3]); w4.z = pk2(o[4], o[5]); w4.w = pk2(o[6], o[7]);
        *(u32x4*)(MIX + (size_t)(t0 + k) * 1024) = w4;
#pragma unroll
        for (int q = 0; q < 4; ++q) { const unsigned v = g == 0 ? rw[14 + k][q] : g == 1 ? rw[12 + k][q] : g == 2 ? rw[8 + k][q] : rw[k][q];
            sum[2 * q] -= __uint_as_float(v << 16); sum[2 * q + 1] -= __uint_as_float(v & 0xffff0000u); } }
}
__device__ __forceinline__ void phase_attn(const Params& p, LAS unsigned char* lds, int tid, int wave, int lane, int rep) {
    const bool probe = PROBE_ATT && REPS(3) == 2 && rep == 0;
    const bool swz = gridDim.x == 256;
#pragma unroll 1
    for (int k = blockIdx.x; k < 1024; k += gridDim.x) { const int xcd = k & 7, local = (k >> 3) & 31, round = k >> 8;
        attn_item(p, lds, swz ? (local & 15) + 16 * (round * 16 + xcd * 2 + (local >> 4)) : k, tid, wave, lane, probe); }
    if (probe) return;
    for (int task = blockIdx.x * 8 + wave; task < T_ / 8; task += gridDim.x * 8) pool_wave(p, task, lane);
}

typedef unsigned u32x2s __attribute__((ext_vector_type(2)));
#define CE_DESC(a, b) do { const float _x = (a), _y = (b); (a) = fmaxf(_x, _y); (b) = fminf(_x, _y); } while (0)
template <int N, int K, int J, int I> __device__ __forceinline__ void bs_i(float (&v)[N]) {
    if constexpr (I < N) {
        constexpr int L = I ^ J;
        if constexpr (L > I) { const float x = v[I], y = v[L]; const float mx = fmaxf(x, y), mn = fminf(x, y);
            if constexpr ((I & K) == 0) { v[I] = mx; v[L] = mn; } else { v[I] = mn; v[L] = mx; } }
        bs_i<N, K, J, I + 1>(v);
    }
}
template <int N, int K, int J> __device__ __forceinline__ void bs_j(float (&v)[N]) { if constexpr (J > 0) { bs_i<N, K, J, 0>(v); bs_j<N, K, J / 2>(v); } }
template <int N, int K> __device__ __forceinline__ void bs_k(float (&v)[N]) { if constexpr (K <= N) { bs_j<N, K, K / 2>(v); bs_k<N, K * 2>(v); } }
template <int N> __device__ __forceinline__ void bitonic_sort_desc(float (&v)[N]) { bs_k<N, 2>(v); }
__device__ __forceinline__ void bitonic_merge_desc16(float (&v)[16]) { bs_j<16, 16, 8>(v); }
__device__ __forceinline__ void sort16_desc(float (&v)[16]) {
    CE_DESC(v[0], v[13]); CE_DESC(v[1], v[12]); CE_DESC(v[2], v[15]); CE_DESC(v[3], v[14]); CE_DESC(v[4], v[8]); CE_DESC(v[5], v[6]); CE_DESC(v[7], v[11]); CE_DESC(v[9], v[10]);
    CE_DESC(v[0], v[5]); CE_DESC(v[1], v[7]); CE_DESC(v[2], v[9]); CE_DESC(v[3], v[4]); CE_DESC(v[6], v[13]); CE_DESC(v[8], v[14]); CE_DESC(v[10], v[15]); CE_DESC(v[11], v[12]);
    CE_DESC(v[0], v[1]); CE_DESC(v[2], v[3]); CE_DESC(v[4], v[5]); CE_DESC(v[6], v[8]); CE_DESC(v[7], v[9]); CE_DESC(v[10], v[11]); CE_DESC(v[12], v[13]); CE_DESC(v[14], v[15]);
    CE_DESC(v[0], v[2]); CE_DESC(v[1], v[3]); CE_DESC(v[4], v[10]); CE_DESC(v[5], v[11]); CE_DESC(v[6], v[7]); CE_DESC(v[8], v[9]); CE_DESC(v[12], v[14]); CE_DESC(v[13], v[15]);
    CE_DESC(v[1], v[2]); CE_DESC(v[3], v[12]); CE_DESC(v[4], v[6]); CE_DESC(v[5], v[7]); CE_DESC(v[8], v[10]); CE_DESC(v[9], v[11]); CE_DESC(v[13], v[14]);
    CE_DESC(v[1], v[4]); CE_DESC(v[2], v[6]); CE_DESC(v[5], v[8]); CE_DESC(v[7], v[10]); CE_DESC(v[9], v[13]); CE_DESC(v[11], v[14]);
    CE_DESC(v[2], v[4]); CE_DESC(v[3], v[6]); CE_DESC(v[9], v[12]); CE_DESC(v[11], v[13]);
    CE_DESC(v[3], v[5]); CE_DESC(v[6], v[8]); CE_DESC(v[7], v[9]); CE_DESC(v[10], v[12]);
    CE_DESC(v[3], v[4]); CE_DESC(v[5], v[6]); CE_DESC(v[7], v[8]); CE_DESC(v[9], v[10]); CE_DESC(v[11], v[12]);
    CE_DESC(v[6], v[7]); CE_DESC(v[8], v[9]);
}
__device__ __forceinline__ void merge_top16(float (&a)[16], const float (&b)[16]) {
#pragma unroll
    for (int i = 0; i < 16; ++i) a[i] = fmaxf(a[i], b[15 - i]);
    bitonic_merge_desc16(a);
}
__device__ __forceinline__ void cross_half_merge(float (&a)[16]) {
    float o[16];
#pragma unroll
    for (int i = 0; i < 16; ++i) { const u32x2s r = __builtin_amdgcn_permlane32_swap(__float_as_uint(a[i]), __float_as_uint(a[i]), false, false); a[i] = __uint_as_float(r.x); o[i] = __uint_as_float(r.y); }
    merge_top16(a, o);
}
__device__ constexpr int cand_i(int n) { return n < 15 ? 0 : n < 21 ? 1 : n < 23 ? 2 : n < 27 ? (n - 23) : -1; }
__device__ constexpr int cand_j(int n) { return n < 15 ? (n + 1) : n < 21 ? (n - 15 + 2) : n < 23 ? (n - 21 + 3) : n < 27 ? (n - 23) : -1; }

__device__ __forceinline__ void route_half(const bf16_t* qp, const LAS unsigned char* skl, int i, int h, float (&g0)[16]) {
    bf16x8 qf[8];
#pragma unroll
    for (int s = 0; s < 8; ++s) qf[s] = *(const bf16x8*)(qp + 16 * s);
#pragma unroll
    for (int mt = 0; mt < 4; ++mt) {
        f32x16 acc;
#pragma unroll
        for (int e = 0; e < 16; ++e) acc[e] = 0.f;
#pragma unroll
        for (int s = 0; s < 8; ++s) { const bf16x8 kf = *(const LAS bf16x8*)(skl + mt * 8192 + i * 256 + ((((2 * s + h) ^ (i & 15))) << 4)); acc = __builtin_amdgcn_mfma_f32_32x32x16_bf16(kf, qf[s], acc, 0, 0, 0); }
        float gt[16];
#pragma unroll
        for (int rho = 0; rho < 16; ++rho) { const unsigned key = 32 * mt + (rho & 3) + 8 * (rho >> 2) + 4 * h;
            gt[rho] = __uint_as_float((__float_as_uint(acc[rho]) & ~127u) | key); }
        sort16_desc(gt);
        if (mt == 0) {
#pragma unroll
            for (int e = 0; e < 16; ++e) g0[e] = gt[e];
        } else merge_top16(g0, gt);
        __builtin_amdgcn_sched_barrier(0);
    }
    cross_half_merge(g0);
}
__device__ __forceinline__ void route_unit(const Params& p, const LAS unsigned char* skl, LAS unsigned char* scr, int unit, int lane) {
    const bf16_t* QP = (const bf16_t*)(p.ws + WS_QKVU);
    const int hd = unit & 7, t0 = (unit >> 3) * 32;
    const int i = lane & 31, h = lane >> 5;
    float topA[16], topB[16];
    route_half(QP + (size_t)(t0 + i) * 2048 + hd * 256 + 8 * h, skl, i, h, topA);
    __builtin_amdgcn_sched_barrier(0);
    route_half(QP + (size_t)(t0 + i) * 2048 + hd * 256 + 128 + 8 * h, skl + 32768, i, h, topB);
    __builtin_amdgcn_sched_barrier(0);
    LAS unsigned* sw32 = (LAS unsigned*)(scr + i * 32);
    if (h == 0) {
#pragma unroll
        for (int q = 0; q < 4; ++q) {
            sw32[q] = (__float_as_uint(topA[4 * q]) & 127u) | ((__float_as_uint(topA[4 * q + 1]) & 127u) << 8) | ((__float_as_uint(topA[4 * q + 2]) & 127u) << 16) | ((__float_as_uint(topA[4 * q + 3]) & 127u) << 24);
            sw32[4 + q] = (__float_as_uint(topB[4 * q]) & 127u) | ((__float_as_uint(topB[4 * q + 1]) & 127u) << 8) | ((__float_as_uint(topB[4 * q + 2]) & 127u) << 16) | ((__float_as_uint(topB[4 * q + 3]) & 127u) << 24);
        }
    }
    float X[16], Y[16];
#pragma unroll
    for (int e = 0; e < 16; ++e) { X[e] = h ? topB[e] : topA[e]; Y[e] = h ? topA[e] : topB[e]; }
    float c0[16], c1[16];
#pragma unroll
    for (int n = 0; n < 32; ++n) {
        float v;
        if (n < 27) { const int ci = cand_i(n), cj = cand_j(n);
            const float sum = X[ci] + Y[cj];
            const unsigned code = h ? (unsigned)((cj << 4) | ci) : (unsigned)((ci << 4) | cj);
            v = __uint_as_float((__float_as_uint(sum) & ~255u) | code);
            if (n >= 23) v = h ? -INFINITY : v; }
        else v = -INFINITY;
        if (n < 16) c0[n] = v; else c1[n - 16] = v;
    }
    sort16_desc(c0); sort16_desc(c1);
    merge_top16(c0, c1);
    cross_half_merge(c0);
    const float LOG2E = 1.4426950408889634f;
    float ge[16]; float Z = 0.f;
#pragma unroll
    for (int k = 0; k < 16; ++k) { ge[k] = fast_exp2((c0[k] - c0[0]) * LOG2E); Z += ge[k]; }
    const float invZ = 1.0f / Z;
    const LAS unsigned char* sb = (const LAS unsigned char*)(scr + i * 32);
    unsigned eid[16];
#pragma unroll
    for (int k = 0; k < 16; ++k) { const unsigned code = __float_as_uint(c0[k]) & 255u; const unsigned ai = sb[code >> 4], bi = sb[16 + (code & 15)]; eid[k] = ai * 128u + bi; }
    const size_t slot = (size_t)(t0 + i) * 128 + hd * 16;
    if (h == 0) {
        unsigned short* E = (unsigned short*)(p.ws + WS_EID) + slot;
        u32x4 w0, w1;
        w0.x = eid[0] | (eid[1] << 16); w0.y = eid[2] | (eid[3] << 16); w0.z = eid[4] | (eid[5] << 16); w0.w = eid[6] | (eid[7] << 16);
        w1.x = eid[8] | (eid[9] << 16); w1.y = eid[10] | (eid[11] << 16); w1.z = eid[12] | (eid[13] << 16); w1.w = eid[14] | (eid[15] << 16);
        *(u32x4*)E = w0; *(u32x4*)(E + 8) = w1;
    } else {
        float* G = (float*)(p.ws + WS_GATE) + slot;
#pragma unroll
        for (int q = 0; q < 4; ++q) *(f32x4*)(G + 4 * q) = (f32x4){ge[4 * q] * invZ, ge[4 * q + 1] * invZ, ge[4 * q + 2] * invZ, ge[4 * q + 3] * invZ};
    }
}
__device__ __forceinline__ void phase_route(const Params& p, LAS unsigned char* lds, int tid, int gw, int nw, int wave, int lane) {
    { const u32x4* src = (const u32x4*)(p.ws + WS_SK);
#pragma unroll
      for (int it = 0; it < 8; ++it) { const int idx = it * 512 + tid, n = (idx >> 4) & 127, c = idx & 15, pp = idx >> 11;
          *(LAS u32x4*)(lds + pp * 32768 + n * 256 + ((c ^ (n & 15)) << 4)) = src[idx]; } }
    __syncthreads();
    LAS unsigned char* scr = lds + 65536 + wave * 1024;
    for (int u = gw; u < (T_ / 32) * 8; u += nw) route_unit(p, lds, scr, u, lane);
}

#define XB_TMO      128
#define XB_XCNT(j)  (256  + 64 * (j))
#define XB_XSUB(j)  (1280 + 64 * (j))
#define XB_XGEN(j)  (2304 + 64 * (j))
#define XB_TOP      3328
#define XB_TOPGEN   3392
#define XCD_BAR_WORDS 3456
#define XB_SPIN_CAP (1u << 20)
__device__ __forceinline__ unsigned xb_ld(unsigned* p)              { return __hip_atomic_load(p, __ATOMIC_RELAXED, __HIP_MEMORY_SCOPE_AGENT); }
__device__ __forceinline__ unsigned xb_add(unsigned* p, unsigned v) { return __hip_atomic_fetch_add(p, v, __ATOMIC_RELAXED, __HIP_MEMORY_SCOPE_AGENT); }
__device__ __forceinline__ unsigned xb_xcc_id() { return (unsigned)__builtin_amdgcn_s_getreg((3 << 11) | 20) & 0xFu; }
#define XB_SPIN(cond, bar) do { unsigned _sp = 0; while (cond) { __builtin_amdgcn_s_sleep(1); \
    if ((++_sp & 255u) == 0u) { if (xb_ld(&(bar)[XB_TMO])) break; if (_sp > XB_SPIN_CAP) { atomicAdd(&(bar)[XB_TMO], 1u); break; } } } } while (0)
struct XcdBarrier { unsigned* bar; unsigned x; volatile LAS unsigned* st; int w0; };
__device__ __forceinline__ XcdBarrier xcd_barrier_post(unsigned* bar, volatile LAS unsigned* st, int w0) {
    XcdBarrier b; b.bar = bar; b.x = xb_xcc_id(); b.st = st; b.w0 = w0;
    if (w0 == 0 && lane_id_() == 0) (void)xb_add(&bar[XB_XCNT(b.x)], 1u);
    return b;
}
__device__ __forceinline__ void xcd_barrier_complete(unsigned* bar, unsigned x, unsigned& nloc, unsigned& nx) {
    const unsigned G = gridDim.x * gridDim.y * gridDim.z;
    unsigned sum, cnt, mine, sp = 0u;
    for (;;) {
        sum = 0u; cnt = 0u; mine = 0u;
#pragma unroll
        for (unsigned j = 0; j < 16; ++j) { const unsigned c = xb_ld(&bar[XB_XCNT(j)]); sum += c; cnt += (c > 0u) ? 1u : 0u; mine = (j == x) ? c : mine; }
        if (sum == G) break;
        __builtin_amdgcn_s_sleep(1);
        if ((++sp & 255u) == 0u) { if (xb_ld(&bar[XB_TMO])) break; if (sp > XB_SPIN_CAP) { atomicAdd(&bar[XB_TMO], 1u); break; } }
    }
    nloc = mine > 0u ? mine : 1u; nx = cnt > 0u ? cnt : 1u;
}
__device__ __forceinline__ void xcd_barrier(const XcdBarrier& b) {
    asm volatile("s_waitcnt vmcnt(0)" ::: "memory");
    __syncthreads();
    if (b.w0 == 0 && lane_id_() == 0) {
        unsigned* bar = b.bar;
        __builtin_amdgcn_s_waitcnt(0);
        unsigned nloc = b.st[0], nx = b.st[1];
        if (nloc == 0u) { xcd_barrier_complete(bar, b.x, nloc, nx); b.st[0] = nloc; b.st[1] = nx; }
        const unsigned old = xb_add(&bar[XB_XSUB(b.x)], 1u);
        const unsigned gen = old / nloc;
        if (old + 1u == (gen + 1u) * nloc) {
            __builtin_amdgcn_fence(__ATOMIC_RELEASE, "agent");
            asm volatile("s_waitcnt vmcnt(0)" ::: "memory");
            const unsigned og = xb_add(&bar[XB_TOP], 1u);
            const unsigned tg = og / nx;
            if (og + 1u == (tg + 1u) * nx) xb_add(&bar[XB_TOPGEN], 1u);
            else XB_SPIN(xb_ld(&bar[XB_TOPGEN]) == tg, bar);
            __builtin_amdgcn_fence(__ATOMIC_ACQUIRE, "agent");
            xb_add(&bar[XB_XGEN(b.x)], 1u);
            asm volatile("s_waitcnt vmcnt(0)" ::: "memory");
        } else {
            XB_SPIN(xb_ld(&bar[XB_XGEN(b.x)]) == gen, bar);
            __builtin_amdgcn_fence(__ATOMIC_ACQUIRE, "agent");
            asm volatile("s_waitcnt vmcnt(0)" ::: "memory");
        }
    }
    __syncthreads();
}

__device__ __forceinline__ float gelu_exact(float v) { return 0.5f * v * (1.0f + erff(v * 0.70710678118654752f)); }
constexpr int PEER_TPW = 32, PEER_NCH = T_ / PEER_TPW;
__device__ __forceinline__ int grab_item(unsigned* head, int lane) {
    unsigned v = 0u;
    if (lane == 0) v = __hip_atomic_fetch_add(head, 1u, __ATOMIC_RELAXED, __HIP_MEMORY_SCOPE_AGENT);
    return __builtin_amdgcn_readfirstlane((int)v);
}
typedef float f32x2v __attribute__((ext_vector_type(2)));
typedef int i32x8 __attribute__((ext_vector_type(8)));
struct USmall { unsigned ew, hw0, hw1; float hs; u32x4 ea, eb; };
__device__ __forceinline__ void u_load_small(USmall& s, const unsigned short* eidrow, const bf16_t* hrow, const float* hscp, int lane) {
    s.ew = ((const unsigned*)eidrow)[(unsigned)lane];
    const u32x2 hh = ((const u32x2*)hrow)[(unsigned)lane]; s.hw0 = hh.x; s.hw1 = hh.y;
    unsigned z = 0; asm volatile("" : "+v"(z)); s.hs = hscp[z];
}
__device__ __forceinline__ void u_spread_small(USmall& s, int r) {
#pragma unroll
    for (int q = 0; q < 4; ++q) { s.ea[q] = __shfl(s.ew, 8 * r + q); s.eb[q] = __shfl(s.ew, 8 * r + 4 + q); }
}
__device__ __forceinline__ void u_compute(const USmall& s, const u32x4 (&ur)[16], LAS float* partrow, LAS unsigned char* scr, int lane, int i, int g) {
    const float sc8 = __uint_as_float(0x7f000000u - __float_as_uint(s.hs));
    int hw8 = __builtin_amdgcn_cvt_pk_fp8_f32(__uint_as_float(s.hw0 << 16) * sc8, __uint_as_float(s.hw0 & 0xffff0000u) * sc8, 0, false);
    hw8 = __builtin_amdgcn_cvt_pk_fp8_f32(__uint_as_float(s.hw1 << 16) * sc8, __uint_as_float(s.hw1 & 0xffff0000u) * sc8, hw8, true);
    i32x8 b0, b1;
#pragma unroll
    for (int q = 0; q < 8; ++q) { const int d = 4 * g + (q & 3) + 16 * (q >> 2); b0[q] = __shfl(hw8, d); b1[q] = __shfl(hw8, 32 + d); }
    const int r = lane >> 3, c = lane & 7;
    const unsigned wx = 16u * (unsigned)(r * 8 + (c ^ (r >> 1))), wy = 16u * (unsigned)(64 + r * 8 + (c ^ (4 + (r >> 1))));
    const unsigned ra = 16u * (unsigned)(i * 8 + (g ^ (i >> 1))), rb = 16u * (unsigned)(i * 8 + ((4 + g) ^ (i >> 1)));
    f32x4 acc[8];
#pragma unroll
    for (int half = 0; half < 2; ++half) {
        u32x4 a0[4], a1[4];
#pragma unroll
        for (int t4 = 0; t4 < 4; ++t4) { *(LAS u32x4*)(scr + t4 * 2048 + wx) = ur[4 * half + t4]; *(LAS u32x4*)(scr + t4 * 2048 + wy) = ur[8 + 4 * half + t4]; }
#pragma unroll
        for (int t4 = 0; t4 < 4; ++t4) { a0[t4] = *(const LAS u32x4*)(scr + t4 * 2048 + ra); a1[t4] = *(const LAS u32x4*)(scr + t4 * 2048 + rb); }
#pragma unroll
        for (int t4 = 0; t4 < 4; ++t4) { f32x4 a = {0.f, 0.f, 0.f, 0.f};
            i32x8 p0, p1;
            p0[0] = (int)a0[t4][0]; p0[1] = (int)a0[t4][1]; p0[2] = (int)a0[t4][2]; p0[3] = (int)a0[t4][3]; p0[4] = 0; p0[5] = 0; p0[6] = 0; p0[7] = 0;
            p1[0] = (int)a1[t4][0]; p1[1] = (int)a1[t4][1]; p1[2] = (int)a1[t4][2]; p1[3] = (int)a1[t4][3]; p1[4] = 0; p1[5] = 0; p1[6] = 0; p1[7] = 0;
            a = __builtin_amdgcn_mfma_scale_f32_16x16x128_f8f6f4(p0, b0, a, 4, 0, 0, 0x7f7f7f7f, 0, 0x7f7f7f7f);
            a = __builtin_amdgcn_mfma_scale_f32_16x16x128_f8f6f4(p1, b1, a, 4, 0, 0, 0x7f7f7f7f, 0, 0x7f7f7f7f);
            acc[4 * half + t4] = a; }
    }
#pragma unroll
    for (int tau = 0; tau < 8; ++tau) asm volatile("" : "+v"(acc[tau]));
    const int rho = i & 3, m = i >> 2;
    float sel[8];
#pragma unroll
    for (int tau = 0; tau < 8; ++tau) { const float lo = (rho & 1) ? acc[tau][1] : acc[tau][0], hi2 = (rho & 1) ? acc[tau][3] : acc[tau][2]; sel[tau] = (rho & 2) ? hi2 : lo; }
    float v0 = sel[0], v1 = sel[1];
#pragma unroll
    for (int mm = 1; mm < 4; ++mm) { v0 = (m == mm) ? sel[2 * mm] : v0; v1 = (m == mm) ? sel[2 * mm + 1] : v1; }
    const int R = 4 * g + rho;
    half2_t o; o.x = (_Float16)v0; o.y = (_Float16)v1;
    *(LAS half2_t*)((LAS _Float16*)partrow + (unsigned)(16 * (R & 7) + 8 * (R >> 3) + 2 * m)) = o;
}
__device__ __forceinline__ unsigned eid_of(const u32x4& ea, const u32x4& eb, int it) { const unsigned w = (it < 8) ? ea[(it >> 1) & 3] : eb[(it >> 1) & 3]; return (it & 1) ? (w >> 16) : (w & 0xffffu); }
#ifndef PROBE_SKIP
#define PROBE_SKIP 0
#endif
struct VIds { unsigned ew; u32x4 ea, eb; };
struct VCf { unsigned cw; float csc; };
struct VXm { u32x2 xw; };
__device__ __forceinline__ void v_load_ids(VIds& s, const unsigned short* eidrow, int lane) { s.ew = __builtin_nontemporal_load((const unsigned*)eidrow + (unsigned)lane); }
__device__ __forceinline__ void v_spread_ids(VIds& s, int r) {
#pragma unroll
    for (int q = 0; q < 4; ++q) { s.ea[q] = __shfl(s.ew, 8 * r + q); s.eb[q] = __shfl(s.ew, 8 * r + 4 + q); }
}
__device__ __forceinline__ void v_load_cf(VCf& s, const unsigned char* coefrow, const float* cscp, int lane) {
    s.cw = __builtin_nontemporal_load((const unsigned*)coefrow + (unsigned)(lane & 31));
    unsigned z = 0; asm volatile("" : "+v"(z)); s.csc = cscp[z];
}
__device__ __forceinline__ void v_load_xm(VXm& s, const bf16_t* xrow, unsigned colb) { s.xw = __builtin_nontemporal_load((const u32x2*)(xrow + colb)); }
typedef int i32x2v __attribute__((ext_vector_type(2)));
__device__ __forceinline__ void v_compute(const VCf& s, const VXm& xm, const u32x4 (&vr)[16], const LAS float* gc, LAS float* outrow, LAS unsigned char* gb, int lane, unsigned colb, bool abl = false) {
    const int r = lane >> 3, c = lane & 7, i = lane & 15, g = lane >> 4;
    i32x8 b;
#pragma unroll
    for (int q = 0; q < 8; ++q) b[q] = (int)__shfl(s.cw, 16 * (q >> 2) + 8 * (g >> 1) + 4 * ((q >> 1) & 1) + 2 * (g & 1) + (q & 1));
    const unsigned wb = 144u * (unsigned)(8 * r) + 16u * (unsigned)c, rb = 144u * (unsigned)(16 * g + i);
    f32x4 val0 = {0.f, 0.f, 0.f, 0.f}, val1 = {0.f, 0.f, 0.f, 0.f};
    int iv = i; asm volatile("" : "+v"(iv));
    i32x2v R0[16];
    if (!((PROBE_SKIP & 2) && abl)) {
#pragma unroll
        for (int it = 0; it < 8; ++it) *(LAS u32x4*)(gb + wb + 144 * it) = vr[it]; }
#pragma unroll
    for (int ct = 0; ct < 16; ++ct) R0[ct] = __builtin_amdgcn_ds_read_tr4_b64_v2i32((LAS i32x2v*)(gb + rb + 8 * ct));
    __builtin_amdgcn_sched_barrier(0);
    if (!((PROBE_SKIP & 2) && abl)) {
#pragma unroll
        for (int it = 0; it < 8; ++it) *(LAS u32x4*)(gb + wb + 144 * it) = vr[8 + it]; }
#pragma unroll
    for (int bt = 0; bt < 4; ++bt) {
        i32x2v R1[4];
#pragma unroll
        for (int q = 0; q < 4; ++q) R1[q] = __builtin_amdgcn_ds_read_tr4_b64_v2i32((LAS i32x2v*)(gb + rb + 8 * (4 * bt + q)));
#pragma unroll
        for (int q = 0; q < 4; ++q) { const int ct = 4 * bt + q;
            i32x8 a; a[0] = R0[ct].x; a[1] = R0[ct].y; a[2] = R1[q].x; a[3] = R1[q].y; a[4] = 0; a[5] = 0; a[6] = 0; a[7] = 0;
            const int sb = (iv == ct) ? 0x7f7f7f7f : 0;
            if (q & 1) val1 = __builtin_amdgcn_mfma_scale_f32_16x16x128_f8f6f4(a, b, val1, 4, 0, 0, 0x7f7f7f7f, 0, sb);
            else       val0 = __builtin_amdgcn_mfma_scale_f32_16x16x128_f8f6f4(a, b, val0, 4, 0, 0, 0x7f7f7f7f, 0, sb); }
        __builtin_amdgcn_sched_barrier(0); }
    asm volatile("" : "+v"(val0), "+v"(val1));
    const f32x4 val = val0 + val1;
    const float cs = s.csc;
    const f32x4 gv = *(const LAS f32x4*)(gc + lane * 4);
    f32x4 x2;
    x2[0] = __uint_as_float(xm.xw.x << 16) + gv[0] * (cs * val[0]); x2[1] = __uint_as_float(xm.xw.x & 0xffff0000u) + gv[1] * (cs * val[1]);
    x2[2] = __uint_as_float(xm.xw.y << 16) + gv[2] * (cs * val[2]); x2[3] = __uint_as_float(xm.xw.y & 0xffff0000u) + gv[3] * (cs * val[3]);
    u32x2 w2; w2.x = pk2(x2[0], x2[1]); w2.y = pk2(x2[2], x2[3]);
    *(LAS u32x2*)((LAS bf16_t*)outrow + colb) = w2;
}
__device__ __forceinline__ void gather16(u32x4 (&dst)[16], const unsigned char* tab, const u32x4& ea, const u32x4& eb, int c, bool dead) {
#pragma unroll
    for (int it = 0; it < 16; ++it) { const unsigned e = dead ? 0u : eid_of(ea, eb, it); dst[it] = *(const u32x4*)(tab + (e * 128u + 16u * c)); }
}
#ifndef PROBE_DEAD
#define PROBE_DEAD 0
#endif
struct PeerItem { int P, t0; bool ok; };
__device__ __forceinline__ PeerItem peer_draw(unsigned* heads, int x, int& k, int lane, int nparts, int nch, int tpw) {
    PeerItem it; it.P = 0; it.t0 = 0; it.ok = false;
    while (k < nparts) { const int P = (x + k) & (nparts - 1); const int ch = grab_item(heads + 64 * P, lane);
        if (ch < nch) { it.P = P; it.t0 = ch * tpw; it.ok = true; break; }
        ++k; }
    return it;
}
template <bool VPASS> __device__ __forceinline__ void phase_peer_part(const Params& p, LAS unsigned char* lds, int tid, int wave, int lane, int rep) {
    const bool pdead = PROBE_DEAD && rep > 0;
    unsigned* heads = (unsigned*)(p.ws + WS_BAR) + 4096 + (VPASS ? 512 : 0) + rep * 1024;
    const int x = (int)(xb_xcc_id() & 7u);
    const unsigned short* EID = (const unsigned short*)(p.ws + WS_EID);
    const int r = lane >> 3, c = lane & 7;
    const unsigned colb = 16 * c + 2 * ((lane >> 3) & 1) + 4 * ((lane >> 4) & 1) + 8 * ((lane >> 5) & 1);
    constexpr int TPW = PEER_TPW, NJ = TPW / 2;
    LAS float* wbuf = (LAS float*)(lds + 4096 + wave * (TPW * 512));
    int k = 0;
    if (!VPASS) {
        PeerItem cur = peer_draw(heads, x, k, lane, 4, PEER_NCH, TPW);
        if (!cur.ok) return;
        const int li = lane & 15, lg = lane >> 4;
        const bf16_t* H8b = (const bf16_t*)(p.ws + WS_H); const float* HSCp = (const float*)(p.ws + WS_HSC);
        LAS unsigned char* scr = (LAS unsigned char*)(wbuf + 2048);
        USmall sA, sB, sN; u32x4 A[16], B[16];
        u_load_small(sA, EID + (size_t)cur.t0 * 128, H8b + 256 * cur.P + (size_t)cur.t0 * 1024, HSCp + cur.t0, lane);
        u_load_small(sB, EID + (size_t)(cur.t0 + 1) * 128, H8b + 256 * cur.P + (size_t)(cur.t0 + 1) * 1024, HSCp + cur.t0 + 1, lane);
        u_spread_small(sA, r);
        gather16(A, p.ws + WS_U8 + (size_t)cur.P * 2097152, sA.ea, sA.eb, c, pdead);
        for (;;) {
            const PeerItem nxt = peer_draw(heads, x, k, lane, 4, PEER_NCH, TPW);
            const int P = cur.P, t0 = cur.t0;
            const unsigned char* U8p = p.ws + WS_U8 + (size_t)P * 2097152; const bf16_t* H = H8b + 256 * P;
            _Float16* PART = (pdead ? (_Float16*)p.out : (_Float16*)(p.ws + WS_PART)) + (size_t)P * T_ * 128;
            const unsigned char* U8n = p.ws + WS_U8 + (size_t)(nxt.ok ? nxt.P : P) * 2097152; const bf16_t* Hn = H8b + 256 * (nxt.ok ? nxt.P : P); const int tn = nxt.ok ? nxt.t0 : t0;
#pragma unroll 1
            for (int j = 0; j < NJ; ++j) { const int ta = t0 + 2 * j; const bool last = (j + 1 == NJ);
                { const int t2 = last ? tn : ta + 2; u_load_small(sN, EID + (size_t)t2 * 128, (last ? Hn : H) + (size_t)t2 * 1024, HSCp + t2, lane); }
                __builtin_amdgcn_sched_barrier(0);
                u_spread_small(sB, r);
                gather16(B, U8p, sB.ea, sB.eb, c, pdead);
                __builtin_amdgcn_sched_barrier(0);
                u_compute(sA, A, wbuf + (2 * j) * 64, scr, lane, li, lg);
                { const int t3 = last ? tn + 1 : ta + 3; u_load_small(sA, EID + (size_t)t3 * 128, (last ? Hn : H) + (size_t)t3 * 1024, HSCp + t3, lane); }
                __builtin_amdgcn_sched_barrier(0);
                u_spread_small(sN, r);
                gather16(A, last ? U8n : U8p, sN.ea, sN.eb, c, (last && !nxt.ok) || pdead);
                __builtin_amdgcn_sched_barrier(0);
                u_compute(sB, B, wbuf + (2 * j + 1) * 64, scr, lane, li, lg);
                { const unsigned e2 = sA.ew, h20 = sA.hw0, h21 = sA.hw1; const float hs2 = sA.hs; sA = sN; sB.ew = e2; sB.hw0 = h20; sB.hw1 = h21; sB.hs = hs2; } }
#pragma unroll 4
            for (int q = 0; q < TPW / 4; ++q) { const int idx = q * 64 + lane; const f32x4 v = *(const LAS f32x4*)(wbuf + idx * 4);
                __builtin_nontemporal_store(v, (f32x4*)((float*)(PART + (size_t)t0 * 128) + (size_t)idx * 4)); }
            if (!nxt.ok) break;
            cur = nxt;
        }
    } else {
        constexpr int TV = 8, NJV = TV / 2, NCHV = T_ / TV;
        const unsigned colv = 16 * (lane & 15) + 4 * (lane >> 4);
        LAS float* gc = wbuf + 3584;
        LAS unsigned char* gb = (LAS unsigned char*)(wbuf + 1024);
        PeerItem cur = peer_draw(heads, x, k, lane, 4, NCHV, TV);
        if (!cur.ok) return;
        const unsigned char* COEF = p.ws + WS_COEF; const float* CSC = (const float*)(p.ws + WS_COEF + 16777216); const bf16_t* MXb = (const bf16_t*)(p.ws + WS_X1);
        const float* modb = (const float*)(p.ws + WS_MOD); const float inv_sv = ((const float*)(p.ws + WS_CTL))[65];
        VIds iB, iN; VCf cA, cB; VXm xA, xB; u32x4 A[16], B[16];
        v_load_ids(iN, EID + (size_t)cur.t0 * 128, lane); v_load_ids(iB, EID + (size_t)(cur.t0 + 1) * 128, lane);
        v_load_cf(cA, COEF + (size_t)cur.t0 * 128, CSC + cur.t0, lane);
        v_spread_ids(iN, r);
        gather16(A, p.ws + WS_V8 + (size_t)cur.P * 2097152, iN.ea, iN.eb, c, pdead);
        for (;;) {
            const PeerItem nxt = peer_draw(heads, x, k, lane, 4, NCHV, TV);
            const int P = cur.P, t0 = cur.t0;
            const unsigned char* V8q = p.ws + WS_V8 + (size_t)P * 2097152; const bf16_t* X1 = MXb + 256 * P;
            *(LAS f32x4*)(gc + lane * 4) = *(const f32x4*)(modb + (size_t)(t0 >> 13) * MODW + 5120 + 256 * P + colv) * inv_sv;
            bf16_t* X2 = (bf16_t*)(p.ws + (pdead ? WS_PART : WS_H)) + 256 * P;
            const int Pn = nxt.ok ? nxt.P : P, tn = nxt.ok ? nxt.t0 : t0;
            const unsigned char* V8n = p.ws + WS_V8 + (size_t)Pn * 2097152;
#pragma unroll 1
            for (int j = 0; j < NJV; ++j) { const int ta = t0 + 2 * j; const bool last = (j + 1 == NJV);
                { const int t2 = last ? tn : ta + 2; v_load_ids(iN, EID + (size_t)t2 * 128, lane); }
                v_load_cf(cB, COEF + (size_t)(ta + 1) * 128, CSC + (ta + 1), lane);
                v_load_xm(xA, X1 + (size_t)ta * 1024, colv);
                __builtin_amdgcn_sched_barrier(0);
                v_spread_ids(iB, r);
                gather16(B, V8q, iB.ea, iB.eb, c, pdead);
                __builtin_amdgcn_sched_barrier(0);
                v_compute(cA, xA, A, gc, wbuf + (2 * j) * 128, gb, lane, colv, pdead);
                { const int t3 = last ? tn + 1 : ta + 3; v_load_ids(iB, EID + (size_t)t3 * 128, lane);
                  const int t2 = last ? tn : ta + 2;
                  v_load_cf(cA, COEF + (size_t)t2 * 128, CSC + t2, lane); }
                v_load_xm(xB, X1 + (size_t)(ta + 1) * 1024, colv);
                __builtin_amdgcn_sched_barrier(0);
                v_spread_ids(iN, r);
                gather16(A, last ? V8n : V8q, iN.ea, iN.eb, c, (last && !nxt.ok) || pdead);
                __builtin_amdgcn_sched_barrier(0);
                v_compute(cB, xB, B, gc, wbuf + (2 * j + 1) * 128, gb, lane, colv, pdead); }
#pragma unroll 4
            for (int q = 0; q < TV; ++q) { const u32x2 v = *(const LAS u32x2*)(wbuf + q * 128 + lane * 2);
                __builtin_nontemporal_store(v, (u32x2*)(X2 + (size_t)(t0 + q) * 1024 + lane * 4)); }
            if (!nxt.ok) break;
            cur = nxt;
        }
    }
}
__device__ __forceinline__ void phase_peer_coef(const Params& p, int gw, int nw, int lane) {
    const float inv_su = ((const float*)(p.ws + WS_CTL))[64];
    const u32x4* PART = (const u32x4*)(p.ws + WS_PART); const float* GATE = (const float*)(p.ws + WS_GATE); u32x2* COEF = (u32x2*)(p.ws + WS_COEF); float* CSC = (float*)(p.ws + WS_COEF + 16777216);
    for (int chunk = gw; chunk < T_ / 32; chunk += nw)
#pragma unroll 2
        for (int rr = 0; rr < 8; ++rr) { const size_t o = ((size_t)chunk * 32 + rr * 4) * 16 + lane;
            float s[8];
#pragma unroll
            for (int k = 0; k < 8; ++k) s[k] = 0.f;
#pragma unroll
            for (int P = 0; P < 4; ++P) { const u32x4 w = PART[(size_t)P * T_ * 16 + o];
#pragma unroll
                for (int q = 0; q < 4; ++q) { const unsigned wq = w[q]; const half2_t hh = __builtin_bit_cast(half2_t, wq); s[2 * q] += (float)hh.x; s[2 * q + 1] += (float)hh.y; } }
            const f32x4 g0 = *(const f32x4*)(GATE + o * 8), g1 = *(const f32x4*)(GATE + o * 8 + 4);
            const float isc = inv_su * ((const float*)(p.ws + WS_HSC))[o >> 4];
            float cf[8]; float mx = 0.f;
#pragma unroll
            for (int k = 0; k < 8; ++k) { const float gk = k < 4 ? g0[k] : g1[k - 4]; cf[k] = gk * gelu_exact(s[k] * isc); mx = fmaxf(mx, fabsf(cf[k])); }
#pragma unroll
            for (int d = 1; d < 16; d <<= 1) mx = fmaxf(mx, __shfl_xor(mx, d));
            const float sc = __uint_as_float(__float_as_uint(448.0f / fmaxf(mx, 1e-20f)) & 0x7f800000u);
            u32x2 c;
            { int w = __builtin_amdgcn_cvt_pk_fp8_f32(cf[0] * sc, cf[1] * sc, 0, false); w = __builtin_amdgcn_cvt_pk_fp8_f32(cf[2] * sc, cf[3] * sc, w, true); c.x = (unsigned)w; }
            { int w = __builtin_amdgcn_cvt_pk_fp8_f32(cf[4] * sc, cf[5] * sc, 0, false); w = __builtin_amdgcn_cvt_pk_fp8_f32(cf[6] * sc, cf[7] * sc, w, true); c.y = (unsigned)w; }
            COEF[o] = c;
            if ((lane & 15) == 0) CSC[o >> 4] = __uint_as_float(0x7f000000u - __float_as_uint(sc)); }
}
__device__ __forceinline__ void phase_final_norm(const Params& p, int gw, int nw, int lane) {
    f32x4 fg[4];
#pragma unroll
    for (int j = 0; j < 4; ++j) fg[j] = *(const f32x4*)(p.final_g + lane * 4 + 256 * j);
    for (int chunk = gw; chunk < T_ / 32; chunk += nw)
#pragma unroll 4
        for (int rr = 0; rr < 32; ++rr) { const size_t t = (size_t)chunk * 32 + rr;
            float* orow = p.out + t * 1024 + lane * 4; const bf16_t* xrow = (const bf16_t*)(p.ws + WS_H) + t * 1024 + lane * 4;
            f32x4 v[4]; float ss = 0.f;
#pragma unroll
            for (int j = 0; j < 4; ++j) { const u32x2 mw = *(const u32x2*)(xrow + 256 * j);
                v[j] = (f32x4){__uint_as_float(mw.x << 16), __uint_as_float(mw.x & 0xffff0000u), __uint_as_float(mw.y << 16), __uint_as_float(mw.y & 0xffff0000u)};
                ss += (v[j][0] * v[j][0] + v[j][1] * v[j][1]) + (v[j][2] * v[j][2] + v[j][3] * v[j][3]); }
            ss = wave_sum(ss);
            const float rstd = 1.0f / sqrtf(ss * (1.0f / 1024.0f) + 1e-6f);
#pragma unroll
            for (int j = 0; j < 4; ++j) *(f32x4*)(orow + 256 * j) = v[j] * rstd * fg[j]; }
}


#ifndef PROBE_VALU
#define PROBE_VALU 0
#endif
#if PROBE_VALU
__device__ __forceinline__ void valu_probe(const Params& p, int lane) {
    float y[16]; const float* src = (const float*)(p.ws + WS_MOD);
#pragma unroll
    for (int k = 0; k < 16; ++k) y[k] = src[lane + 64 * k];
    const _Float16 hc = (_Float16)src[lane + 1024];
    unsigned w0 = __float_as_uint(src[lane + 2048]), w1 = __float_as_uint(src[lane + 2112]);
    const float fc = src[lane + 3072];
#pragma unroll 1
    for (int it = 0; it < 4096; ++it) {
#if PROBE_VALU == 1
#pragma unroll
        for (int rep = 0; rep < 2; ++rep)
#pragma unroll
            for (int k = 0; k < 16; ++k) asm volatile("v_fma_f32 %0, %1, %2, %0" : "+v"(y[k]) : "v"(fc), "v"(y[(k + 1) & 15]));
#elif PROBE_VALU == 2
#pragma unroll
        for (int rep = 0; rep < 2; ++rep)
#pragma unroll
            for (int k = 0; k < 16; ++k) asm volatile("v_fma_mix_f32 %0, %1, %2, %0 op_sel_hi:[1,0,0]" : "+v"(y[k]) : "v"(hc), "v"(fc));
#elif PROBE_VALU == 3
#pragma unroll
        for (int rep = 0; rep < 8; ++rep) {
            asm volatile("v_cvt_pk_f32_fp8_e32 %0, %1" : "=v"(*(unsigned long long*)&y[0]) : "v"(w0));
            asm volatile("v_cvt_pk_f32_fp8_sdwa %0, %1 src0_sel:WORD_1" : "=v"(*(unsigned long long*)&y[2]) : "v"(w0));
            asm volatile("v_cvt_pk_f32_fp8_e32 %0, %1" : "=v"(*(unsigned long long*)&y[4]) : "v"(w1));
            asm volatile("v_cvt_pk_f32_fp8_sdwa %0, %1 src0_sel:WORD_1" : "=v"(*(unsigned long long*)&y[6]) : "v"(w1)); }
#elif PROBE_VALU == 4
#pragma unroll
        for (int rep = 0; rep < 4; ++rep)
#pragma unroll
            for (int k = 0; k < 8; ++k) asm volatile("v_pk_fma_f32 %0, %1, %2, %0" : "+v"(*(unsigned long long*)&y[2 * k]) : "v"(*(unsigned long long*)&y[(2 * k + 2) & 15]), "v"(*(unsigned long long*)&y[(2 * k + 4) & 15]));
#elif PROBE_VALU == 5
#pragma unroll
        for (int rep = 0; rep < 16; ++rep) {
            asm volatile("v_cvt_scalef32_pk_f16_fp8 %0, %1, 1.0" : "=v"(w1) : "v"(w0));
            asm volatile("v_cvt_scalef32_pk_f16_fp8 %0, %1, 1.0 op_sel:[1,0,0]" : "=v"(w0) : "v"(w1)); }
#elif PROBE_VALU == 6
#pragma unroll
        for (int rep = 0; rep < 2; ++rep)
#pragma unroll
            for (int k = 0; k < 16; ++k) asm volatile("v_dot2c_f32_f16_e32 %0, %1, %2" : "+v"(y[k]) : "v"(w0), "v"(w1));
#endif
    }
    float sacc = 0.f;
#pragma unroll
    for (int k = 0; k < 16; ++k) sacc += y[k];
    sacc += __uint_as_float(w0) + __uint_as_float(w1);
    if (sacc == 123.456f) ((float*)(p.ws + WS_SSQ))[lane] = sacc;
}
#endif
#ifndef PH_MASK
#define PH_MASK 0xFFF
#endif
#define PHASE_ON(k) (((PH_MASK >> (k)) & 1) && lo <= (k) && (k) < hi)
#define GRID_SYNC(k) do { if ((k) == 0) { __syncthreads(); cg::this_grid().sync(); } else xcd_barrier(xbar); } while (0)
#define RUN_PHASE(k, ...) if (PHASE_ON(k)) { for (int rep_ = 0; rep_ < REPS(k); ++rep_) { __VA_ARGS__ if (rep_ + 1 < REPS(k)) GRID_SYNC(k); } if ((k) + 1 < hi) GRID_SYNC(k); }
#define WAVE_IDS const int lane = lane_id_(), wave = wave0_, tid = wave * 64 + lane; (void)tid; (void)lane; (void)wave;
__global__ void __launch_bounds__(512) mega(Params p) {
    extern __shared__ __attribute__((aligned(16))) unsigned char lds_raw[];
    LAS unsigned char* lds = (LAS unsigned char*)lds_raw;
    const int lo = p.ph_lo, hi = p.ph_hi;
    volatile LAS unsigned* xst = (volatile LAS unsigned*)(lds + LDS_BYTES - 16);
    const int wave0_ = __builtin_amdgcn_readfirstlane((int)threadIdx.x >> 6);
    XcdBarrier xbar; xbar.bar = (unsigned*)(p.ws + WS_BAR); xbar.x = 0; xbar.st = xst; xbar.w0 = wave0_;
    if (hi - lo > 1) { if (wave0_ == 0 && lane_id_() == 0) { xst[0] = 0u; xst[1] = 0u; } __syncthreads(); xbar = xcd_barrier_post((unsigned*)(p.ws + WS_BAR), xst, wave0_); }
    RUN_PHASE(0, { WAVE_IDS phase_prep(p, lds, tid); })
    RUN_PHASE(1, { WAVE_IDS phase_tables_fp8(p, lds, tid); phase_norm(p.x, nullptr, p.norm1_g, (const float*)(p.ws + WS_MOD), 0, 1024, (bf16_t*)(p.ws + WS_H), nullptr, nullptr, blockIdx.x * 8 + wave, gridDim.x * 8, lane); })
    RUN_PHASE(2, { pg8::Gemm g{(const bf16_t*)(p.ws + WS_H), (const bf16_t*)(p.ws + WS_WIN), T_, 2048, 1024}; pg8::StaticOrder S; S.init(T_, 2048, gridDim.x, blockIdx.x);
        pg8::EpiBf16 E{(bf16_t*)(p.ws + WS_QKVU), 2048, 2, 0.125f * 1.4426950408889634f}; pg8::gemm_phase<pg8::EpiBf16, pg8::StaticOrder>(lds, g, S, E, wave0_ * 64 + lane_id_()); })
    RUN_PHASE(3, { WAVE_IDS phase_attn(p, lds, tid, wave, lane, rep_); })
    RUN_PHASE(4, { pg8::Gemm g{(const bf16_t*)(p.ws + WS_H), (const bf16_t*)(p.ws + WS_WOUT), T_, 1024, 1024}; pg8::StaticOrder S; S.init(T_, 1024, gridDim.x, blockIdx.x);
        pg8::EpiResB E{p.x, (bf16_t*)(p.ws + WS_X1), (const float*)(p.ws + WS_MOD) + 2048}; pg8::gemm_phase<pg8::EpiResB, pg8::StaticOrder>(lds, g, S, E, wave0_ * 64 + lane_id_()); })
    RUN_PHASE(5, { WAVE_IDS phase_norm(p.x, nullptr, p.norm2_g, (const float*)(p.ws + WS_MOD), 3072, 4096, (bf16_t*)(p.ws + WS_H), p.ws + WS_H8, (float*)(p.ws + WS_HSC), blockIdx.x * 8 + wave, gridDim.x * 8, lane, (const bf16_t*)(p.ws + WS_X1)); })
    RUN_PHASE(6, { pg8::Gemm g{(const bf16_t*)(p.ws + WS_H), (const bf16_t*)(p.ws + WS_WQ), T_, 2048, 1024}; pg8::StaticOrder S; S.init(T_, 2048, gridDim.x, blockIdx.x);
        pg8::EpiBf16 E{(bf16_t*)(p.ws + WS_QKVU), 2048, 0, 1.0f}; pg8::gemm_phase<pg8::EpiBf16, pg8::StaticOrder>(lds, g, S, E, wave0_ * 64 + lane_id_()); })
    RUN_PHASE(7, { WAVE_IDS phase_route(p, lds, tid, blockIdx.x * 8 + wave, gridDim.x * 8, wave, lane); })
    RUN_PHASE(8, { WAVE_IDS phase_peer_part<false>(p, lds, tid, wave, lane, rep_); })
    RUN_PHASE(9, { WAVE_IDS phase_peer_coef(p, blockIdx.x * 8 + wave, gridDim.x * 8, lane); })
    RUN_PHASE(10, { WAVE_IDS phase_peer_part<true>(p, lds, tid, wave, lane, rep_); })
#if PROBE_VALU
    { WAVE_IDS valu_probe(p, lane); }
#endif
    RUN_PHASE(11, { WAVE_IDS phase_final_norm(p, blockIdx.x * 8 + wave, gridDim.x * 8, lane); })
}

#ifndef PROBE_MF4
#define PROBE_MF4 0
#endif
#if PROBE_MF4
typedef int i32x8p __attribute__((ext_vector_type(8)));
__device__ __forceinline__ int mf4_k(int hyp, int g, int n) { return hyp == 0 ? 32 * g + n : 16 * g + (n & 15) + 64 * (n >> 4); }
__global__ void mf4_probe_kernel(Params p) {
    const int l = threadIdx.x & 63, i = l & 15, g = l >> 4;
    unsigned pass = 0;
#pragma unroll
    for (int ha = 0; ha < 2; ++ha)
#pragma unroll
    for (int hb = 0; hb < 2; ++hb) {
        i32x8p a;
#pragma unroll
        for (int q = 0; q < 8; ++q) a[q] = 0;
        const int kk = (37 * i + 5) % 128;
#pragma unroll
        for (int n = 0; n < 32; ++n) if (mf4_k(ha, g, n) == kk) {
#pragma unroll
            for (int q = 0; q < 4; ++q) if ((n >> 3) == q) a[q] |= 2 << (4 * (n & 7)); }
        bool ok = true;
#pragma unroll
        for (int part = 0; part < 2; ++part) {
            i32x8p b;
#pragma unroll
            for (int q = 0; q < 8; ++q) { float v[4];
#pragma unroll
                for (int z = 0; z < 4; ++z) { const int k = mf4_k(hb, g, 4 * q + z); v[z] = (float)((part ? (k >> 4) : (k & 15)) + (i & 1)); }
                int w = __builtin_amdgcn_cvt_pk_fp8_f32(v[0], v[1], 0, false); w = __builtin_amdgcn_cvt_pk_fp8_f32(v[2], v[3], w, true); b[q] = w; }
            f32x4 acc = {0.f, 0.f, 0.f, 0.f};
            acc = __builtin_amdgcn_mfma_scale_f32_16x16x128_f8f6f4(a, b, acc, 4, 0, 0, 0x7f7f7f7f, 0, 0x7f7f7f7f);
#pragma unroll
            for (int rg = 0; rg < 4; ++rg) { const int row = 4 * g + rg; const int kr = (37 * row + 5) % 128; const float ref = (float)((part ? (kr >> 4) : (kr & 15)) + (i & 1)); ok &= (acc[rg] == ref); }
        }
        if (__all(ok)) pass |= 1u << (2 * ha + hb);
    }
    if (l == 0) p.out[5] = 1.0e6f * (float)(1u + 2u * pass);
}
#endif
#ifndef PROBE_UCHK
#define PROBE_UCHK 0
#endif
#if PROBE_UCHK
__device__ __forceinline__ float dec_fp4(unsigned c) { const float m[8] = {0.f, .5f, 1.f, 1.5f, 2.f, 3.f, 4.f, 6.f}; float v = 0.f;
#pragma unroll
    for (int k = 0; k < 8; ++k) v = ((c & 7u) == (unsigned)k) ? m[k] : v;
    return (c & 8u) ? -v : v; }
__global__ void uchk_kernel(Params p, unsigned* flags) {
    const int gt = blockIdx.x * blockDim.x + threadIdx.x;
    const int t = ((gt >> 7) * 257 + 3) & 65535, slot = gt & 127;
    const bf16_t* H = (const bf16_t*)(p.ws + WS_H); const unsigned char* H8 = p.ws + WS_H8; const float hsc = ((const float*)(p.ws + WS_HSC))[t];
    unsigned bad = 0;
    if (!(hsc > 1e-6f && hsc < 64.f)) bad |= 2u;
    for (int c = slot; c < 1024; c += 128) { const float h = bf2f(H[(size_t)t * 1024 + c]); const unsigned w = *(const unsigned*)(H8 + (size_t)t * 1024 + (c & ~3));
        const float q = (c & 3) == 0 ? __builtin_amdgcn_cvt_f32_fp8((int)w, 0) : (c & 3) == 1 ? __builtin_amdgcn_cvt_f32_fp8((int)w, 1) : (c & 3) == 2 ? __builtin_amdgcn_cvt_f32_fp8((int)w, 2) : __builtin_amdgcn_cvt_f32_fp8((int)w, 3);
        if (fabsf(q * hsc - h) > 0.07f * fabsf(h) + 0.02f) bad |= 1u; }
    const unsigned e = ((const unsigned short*)(p.ws + WS_EID))[(size_t)t * 128 + slot];
    for (int P = 0; P < 4; ++P) { float ref = 0.f;
        for (int c = 0; c < 256; ++c) { const unsigned char ub = (p.ws + WS_U8)[((size_t)P * 16384 + e) * 128 + (c >> 1)]; const unsigned code = (c & 1) ? (ub >> 4) : (ub & 15u);
            const unsigned w = *(const unsigned*)(H8 + (size_t)t * 1024 + 256 * P + (c & ~3));
            const float q = (c & 3) == 0 ? __builtin_amdgcn_cvt_f32_fp8((int)w, 0) : (c & 3) == 1 ? __builtin_amdgcn_cvt_f32_fp8((int)w, 1) : (c & 3) == 2 ? __builtin_amdgcn_cvt_f32_fp8((int)w, 2) : __builtin_amdgcn_cvt_f32_fp8((int)w, 3);
            ref += dec_fp4(code) * q; }
        const float got = (float)((const _Float16*)(p.ws + WS_PART))[((size_t)P * T_ + t) * 128 + slot];
        if (fabsf(got - ref) > 0.01f * fabsf(ref) + 2.0f) bad |= 4u; }
    if (bad) atomicOr(flags, bad);
}
__global__ void uchk_report(Params p, const unsigned* flags) { p.out[5] = 1.0e6f * (float)(1u + 2u * flags[0]); }
#endif

#ifndef PROBE_TR4
#define PROBE_TR4 0
#endif
#if PROBE_TR4
typedef int i32x2p __attribute__((ext_vector_type(2)));
typedef int i32x8q __attribute__((ext_vector_type(8)));
__global__ void tr4_probe_kernel(Params p) {
    __shared__ unsigned char sm[4096];
    LAS unsigned char* L = (LAS unsigned char*)sm;
    const int l = threadIdx.x & 63, i = l & 15, g = l >> 4;
    unsigned pass = 0;
    { unsigned w0 = 0, w1 = 0;
#pragma unroll
      for (int kap = 0; kap < 8; ++kap) { w0 |= (unsigned)((3 * i + 5 * kap + g) & 15) << (4 * kap); w1 |= (unsigned)((3 * i + 5 * (kap + 8) + g) & 15) << (4 * kap); }
      *(LAS unsigned*)(L + l * 8) = w0; *(LAS unsigned*)(L + l * 8 + 4) = w1;
      __syncthreads();
      const i32x2p rr = __builtin_amdgcn_ds_read_tr4_b64_v2i32((LAS i32x2p*)(L + l * 8));
      bool ok = true;
#pragma unroll
      for (int n = 0; n < 16; ++n) { const unsigned got = ((unsigned)(n < 8 ? rr.x : rr.y) >> (4 * (n & 7))) & 15u; ok &= (got == (unsigned)((3 * n + 5 * i + g) & 15)); }
      if (__all(ok)) pass |= 1u;
      __syncthreads(); }
    {
      for (int k = l; k < 128; k += 64) { unsigned w0 = 0, w1 = 0;
#pragma unroll
          for (int col = 0; col < 8; ++col) { w0 |= (unsigned)((7 * k + 3 * col) & 7) << (4 * col); w1 |= (unsigned)((7 * k + 3 * (col + 8)) & 7) << (4 * col); }
          *(LAS unsigned*)(L + k * 8) = w0; *(LAS unsigned*)(L + k * 8 + 4) = w1; }
      __syncthreads();
      const i32x2p r0 = __builtin_amdgcn_ds_read_tr4_b64_v2i32((LAS i32x2p*)(L + (32 * g + i) * 8));
      const i32x2p r1 = __builtin_amdgcn_ds_read_tr4_b64_v2i32((LAS i32x2p*)(L + (32 * g + 16 + i) * 8));
      i32x8q a; a[0] = r0.x; a[1] = r0.y; a[2] = r1.x; a[3] = r1.y; a[4] = 0; a[5] = 0; a[6] = 0; a[7] = 0;
      i32x8q b;
#pragma unroll
      for (int q = 0; q < 8; ++q) { const int k0 = 16 * g + 4 * (q & 3) + 64 * (q >> 2);
          int w = __builtin_amdgcn_cvt_pk_fp8_f32((float)((5 * (k0 + 0)) & 7), (float)((5 * (k0 + 1)) & 7), 0, false);
          w = __builtin_amdgcn_cvt_pk_fp8_f32((float)((5 * (k0 + 2)) & 7), (float)((5 * (k0 + 3)) & 7), w, true); b[q] = w; }
      f32x4 acc = {0.f, 0.f, 0.f, 0.f};
      acc = __builtin_amdgcn_mfma_scale_f32_16x16x128_f8f6f4(a, b, acc, 4, 0, 0, 0x7f7f7f7f, 0, 0x7f7f7f7f);
      const float mag[8] = {0.f, .5f, 1.f, 1.5f, 2.f, 3.f, 4.f, 6.f};
      bool ok = true;
#pragma unroll
      for (int rg = 0; rg < 4; ++rg) { const int col = 4 * g + rg; float ref = 0.f;
          for (int k = 0; k < 128; ++k) { const int code = (7 * k + 3 * col) & 7; float mv = 0.f;
#pragma unroll
              for (int z = 0; z < 8; ++z) mv = (code == z) ? mag[z] : mv;
              ref += mv * (float)((5 * k) & 7); }
          ok &= (acc[rg] == ref); }
      if (__all(ok)) pass |= 2u; }
    if (l == 0) p.out[5] = 1.0e6f * (float)(1u + 2u * pass);
}
#endif

#if DEBUG_CHECKS
__device__ __forceinline__ unsigned hash32(unsigned a) { a ^= a >> 16; a *= 0x7feb352du; a ^= a >> 15; a *= 0x846ca68bu; a ^= a >> 16; return a; }
__device__ __forceinline__ void dbg_rec(const Params& p, int k, float err) { if (!(err >= 0.f)) err = 1e30f; atomicMax((unsigned*)(p.ws + WS_CTL) + k, __float_as_uint(err)); }
__device__ __forceinline__ float relerr(float got, float ref, float floor_) { return fabsf(got - ref) / (fabsf(ref) + floor_); }
__device__ __forceinline__ float h2f(unsigned short h) { return (float)__builtin_bit_cast(_Float16, h); }

__global__ void __launch_bounds__(512) check_kernel(Params p, int which) {
    __shared__ float sscr[8][256];
    const int tid = threadIdx.x, lane = tid & 63, wave = tid >> 6, gw = blockIdx.x * 8 + wave;
    const float* mod = (const float*)(p.ws + WS_MOD);
    const unsigned hs = hash32(gw * 2654435761u + which * 97u + 12345u);
    if (which == 0) {
        { const int b = hs & 7, col = (hs >> 3) % MODW; float s = 0.f;
          for (int k = lane; k < 1024; k += 64) { const float v = p.c[b * 1024 + k]; s += (v / (1.0f + expf(-v))) * p.w_ada[(size_t)k * MODW + col]; }
          s = wave_sum(s) + p.b_ada[col]; dbg_rec(p, 0, relerr(mod[b * MODW + col], s, 0.05f)); }
        { const int n = (hs >> 5) % 1536, k = (hs >> 16) & 1023;
          const bf16_t* W1 = (const bf16_t*)(p.ws + WS_WIN); dbg_rec(p, 1, W1[(size_t)n * 1024 + k] == f2bf(p.w_in[(size_t)k * 2048 + n]) ? 0.f : 1.f);
          const int n2 = n & 1023; const bf16_t* W2 = (const bf16_t*)(p.ws + WS_WOUT); dbg_rec(p, 1, W2[(size_t)n2 * 1024 + k] == f2bf(p.w_out[(size_t)k * 1024 + n2]) ? 0.f : 1.f);
          const int n3 = (hs >> 4) & 2047; const bf16_t* W3 = (const bf16_t*)(p.ws + WS_WQ); dbg_rec(p, 1, W3[(size_t)n3 * 1024 + k] == f2bf(p.peer_wq[(size_t)k * 2048 + n3]) ? 0.f : 1.f);
          const unsigned si = hs & 32767; const bf16_t* S = (const bf16_t*)(p.ws + WS_SK); dbg_rec(p, 1, S[si] == f2bf(p.peer_sk[si]) ? 0.f : 1.f);
          const size_t ei = (size_t)(hs & 0xFFFFFF); const unsigned short* U = (const unsigned short*)(p.ws + WS_U16); const unsigned short* V = (const unsigned short*)(p.ws + WS_V16);
          dbg_rec(p, 1, relerr(h2f(U[ei]), p.peer_u[ei], 1e-4f) > 2e-3f ? 1.f : 0.f); dbg_rec(p, 1, relerr(h2f(V[ei]), p.peer_v[ei], 1e-4f) > 2e-3f ? 1.f : 0.f); }
        { const int g = hs & 3, e = (hs >> 2) & 127, k = (hs >> 9) & 1023; float s = 0.f;
          for (int c = lane; c < 128; c += 64) s += p.w_in[(size_t)k * 2048 + 1536 + g * 128 + c] * p.pool_w[(size_t)g * 16384 + c * 128 + e];
          s = wave_sum(s) * p.pool_scale[g * 128 + e];
          const bf16_t* W1 = (const bf16_t*)(p.ws + WS_WIN); dbg_rec(p, 2, relerr(bf2f(W1[(size_t)(1536 + g * 128 + e) * 1024 + k]), s, 0.01f)); }
    } else if (which == 1 || which == 5) {
        const int t = hs & 65535, b = t >> 13; const float* X = which == 1 ? p.x : (const float*)(p.ws + WS_X1); const float* gv = which == 1 ? p.norm1_g : p.norm2_g;
        const int sh_off = which == 1 ? 0 : 3072, sc_off = which == 1 ? 1024 : 4096;
        float ss = 0.f; for (int c = lane; c < 1024; c += 64) { const float v = X[(size_t)t * 1024 + c]; ss += v * v; }
        ss = wave_sum(ss); const float rstd = 1.0f / sqrtf(ss / 1024.0f + 1e-6f);
        const bf16_t* H = (const bf16_t*)(p.ws + WS_H); float e = 0.f;
        for (int c = lane; c < 1024; c += 64) { const float ref = X[(size_t)t * 1024 + c] * rstd * gv[c] * (1.0f + mod[b * MODW + sc_off + c]) + mod[b * MODW + sh_off + c];
            e = fmaxf(e, relerr(bf2f(H[(size_t)t * 1024 + c]), ref, 0.05f)); }
        dbg_rec(p, which == 1 ? 3 : 7, wave_max(e));
    } else if (which == 2 || which == 6) {
        const bf16_t* H = (const bf16_t*)(p.ws + WS_H); const bf16_t* W = (const bf16_t*)(p.ws + (which == 2 ? WS_WIN : WS_WQ)); const bf16_t* O = (const bf16_t*)(p.ws + WS_QKVU);
        for (int rep = 0; rep < 4; ++rep) { const unsigned h2 = hash32(hs + rep); const int t = h2 & 65535, n = (h2 >> 16) & 2047; float s = 0.f;
            for (int k = lane; k < 1024; k += 64) s += bf2f(H[(size_t)t * 1024 + k]) * bf2f(W[(size_t)n * 1024 + k]);
            s = wave_sum(s); dbg_rec(p, which == 2 ? 4 : 8, relerr(bf2f(O[(size_t)t * 2048 + n]), s, 0.05f)); }
    } else if (which == 3) {
        const bf16_t* QKV = (const bf16_t*)(p.ws + WS_QKVU); const bf16_t* MIX = (const bf16_t*)(p.ws + WS_H);
        { const int t = (gw & 1) ? (hs & 65535) : ((hs & 7) * 8192 + ((hs >> 3) & 2047)), hh = (hs >> 16) & 7, dim = (hs >> 19) & 63; const int pos = t & 8191; const size_t tok0 = (size_t)(t >> 13) * 8192;
          const float slope = exp2f(-(float)(hh + 1));
          float sc[7]; float mx = -1e30f;
#pragma unroll
          for (int q = 0; q < 7; ++q) { const int pi = lane + 64 * q; float s = -1e30f;
              if (pi < 387) { const int br = pi / 129, j = pi % 129, d = 1 << (2 * br), dist = j * d;
                  if (pos - dist >= 0) { s = 0.f; for (int k = 0; k < 64; ++k) s += bf2f(QKV[(size_t)t * 2048 + 64 * hh + k]) * bf2f(QKV[(tok0 + pos - dist) * 2048 + 512 + 64 * hh + k]); s = s * 0.125f - slope * (float)dist; } }
              sc[q] = s; mx = fmaxf(mx, s); }
          mx = wave_max(mx); float z = 0.f, acc = 0.f;
#pragma unroll
          for (int q = 0; q < 7; ++q) { const int pi = lane + 64 * q;
              if (pi < 387) { const int br = pi / 129, j = pi % 129, d = 1 << (2 * br), dist = j * d;
                  if (pos - dist >= 0) { const float e = expf(sc[q] - mx); z += e; acc += e * bf2f(QKV[(tok0 + pos - dist) * 2048 + 1024 + 64 * hh + dim]); } } }
          z = wave_sum(z); acc = wave_sum(acc);
          dbg_rec(p, 5, relerr(bf2f(MIX[(size_t)t * 1024 + 64 * hh + dim]), acc / z, 0.02f)); }
        if (lane == 0) { const unsigned h2 = hash32(hs + 7); const int t = (gw & 1) ? (h2 & 65535) : ((h2 & 7) * 8192 + ((h2 >> 3) & 31)), c = (h2 >> 16) & 511, w = 2 << (c >> 7), pos = t & 8191; float s = 0.f; int cnt = 0;
            for (int q = 0; q < w; ++q) if (pos - q >= 0) { s += bf2f(QKV[(size_t)(t - q) * 2048 + 1536 + c]); ++cnt; }
            const float ref = s / (float)cnt - bf2f(QKV[(size_t)t * 2048 + 1536 + c]);
            dbg_rec(p, 6, relerr(bf2f(MIX[(size_t)t * 1024 + 512 + c]), ref, 0.05f)); }
    } else if (which == 4) {
        const bf16_t* MIX = (const bf16_t*)(p.ws + WS_H); const bf16_t* W = (const bf16_t*)(p.ws + WS_WOUT); const float* X1 = (const float*)(p.ws + WS_X1);
        for (int rep = 0; rep < 4; ++rep) { const unsigned h2 = hash32(hs + rep); const int t = h2 & 65535, n = (h2 >> 16) & 1023, b = t >> 13; float s = 0.f;
            for (int k = lane; k < 1024; k += 64) s += bf2f(MIX[(size_t)t * 1024 + k]) * bf2f(W[(size_t)n * 1024 + k]);
            s = wave_sum(s); const float ref = p.x[(size_t)t * 1024 + n] + mod[b * MODW + 2048 + n] * s;
            dbg_rec(p, 9, relerr(X1[(size_t)t * 1024 + n], ref, 0.05f)); }
    } else if (which == 7) {
        const bf16_t* QP = (const bf16_t*)(p.ws + WS_QKVU); const bf16_t* SK = (const bf16_t*)(p.ws + WS_SK);
        const unsigned short* EID = (const unsigned short*)(p.ws + WS_EID); const float* GATE = (const float*)(p.ws + WS_GATE);
        const int t = hs & 65535, hd = (hs >> 16) & 7; float* sc = sscr[wave];
        for (int idx = lane; idx < 256; idx += 64) { const int pp = idx >> 7, n = idx & 127; float s = 0.f;
            for (int k = 0; k < 128; ++k) s += bf2f(QP[(size_t)t * 2048 + hd * 256 + pp * 128 + k]) * bf2f(SK[(size_t)pp * 16384 + n * 128 + k]);
            sc[idx] = s; }
        __builtin_amdgcn_s_waitcnt(0); __builtin_amdgcn_wave_barrier();
        float err = 0.f;
        if (lane < 16) { const int e = EID[(size_t)t * 128 + hd * 16 + lane], ei = e >> 7, ej = e & 127; const float v = sc[ei] + sc[128 + ej];
            float vmin = v, vmax = v; int dup = 0;
            for (int o = 0; o < 16; ++o) { const int e2 = EID[(size_t)t * 128 + hd * 16 + o]; const float v2 = sc[e2 >> 7] + sc[128 + (e2 & 127)]; vmin = fminf(vmin, v2); vmax = fmaxf(vmax, v2); if (o != lane && e2 == e) dup = 1; }
            if (dup) err = 1.f;
            float z = 0.f; for (int o = 0; o < 16; ++o) { const int e2 = EID[(size_t)t * 128 + hd * 16 + o]; z += expf(sc[e2 >> 7] + sc[128 + (e2 & 127)] - vmax); }
            err = fmaxf(err, relerr(GATE[(size_t)t * 128 + hd * 16 + lane], expf(v - vmax) / z, 0.01f));
            if (lane == 0) { int better = 0; for (int a = 0; a < 128; ++a) for (int bq = 0; bq < 128; ++bq) if (sc[a] + sc[128 + bq] > vmin + 2e-3f) ++better; if (better > 15) err = fmaxf(err, 2.f + (float)better); }
        }
        dbg_rec(p, 10, wave_max(err));
    } else if (which == 8) {
        const float* X1 = (const float*)(p.ws + WS_X1); const unsigned short* EID = (const unsigned short*)(p.ws + WS_EID); const float* GATE = (const float*)(p.ws + WS_GATE);
        const float* CO = (const float*)(p.ws + WS_END); const float* YD = (const float*)(p.ws + WS_END + 33554432);
        if ((gw & 7) == 0) { const int t = (hs & 65535) & ~15, b = t >> 13; float ss = 0.f;
            for (int c = lane; c < 1024; c += 64) { const float v = X1[(size_t)t * 1024 + c]; ss += v * v; }
            ss = wave_sum(ss); const float rstd = 1.0f / sqrtf(ss / 1024.0f + 1e-6f);
            float y[16]; float ec = 0.f;
_Pragma("unroll") for (int q = 0; q < 16; ++q) y[q] = 0.f;
            for (int s = 0; s < 128; ++s) { const int e = EID[(size_t)t * 128 + s]; float dsum = 0.f;
                _Pragma("unroll") for (int q = 0; q < 16; ++q) { const int c = lane + 64 * q; const float hv = X1[(size_t)t * 1024 + c] * rstd * p.norm2_g[c] * (1.0f + mod[b * MODW + 4096 + c]) + mod[b * MODW + 3072 + c]; dsum += hv * p.peer_u[(size_t)e * 1024 + c]; }
                dsum = wave_sum(dsum); const float coef = GATE[(size_t)t * 128 + s] * 0.5f * dsum * (1.0f + erff(dsum * 0.70710678f));
                ec = fmaxf(ec, relerr(CO[(size_t)t * 128 + s], coef, 0.05f));
                _Pragma("unroll") for (int q = 0; q < 16; ++q) y[q] += coef * p.peer_v[(size_t)e * 1024 + lane + 64 * q]; }
            dbg_rec(p, 11, ec);
            float ey = 0.f;
_Pragma("unroll") for (int q = 0; q < 16; ++q) ey = fmaxf(ey, relerr(YD[(size_t)(t >> 4) * 1024 + lane + 64 * q], y[q], 0.1f));
            dbg_rec(p, 12, wave_max(ey));
            float x2[16]; float s2 = 0.f;
_Pragma("unroll") for (int q = 0; q < 16; ++q) { const int c = lane + 64 * q; x2[q] = X1[(size_t)t * 1024 + c] + mod[b * MODW + 5120 + c] * y[q]; s2 += x2[q] * x2[q]; }
            s2 = wave_sum(s2); const float r3 = 1.0f / sqrtf(s2 / 1024.0f + 1e-6f); float e = 0.f;
_Pragma("unroll") for (int q = 0; q < 16; ++q) { const int c = lane + 64 * q; e = fmaxf(e, relerr(p.out[(size_t)t * 1024 + c], x2[q] * r3 * p.final_g[c], 0.2f)); }
            dbg_rec(p, 13, wave_max(e)); }
    }
}
__global__ void report_kernel(Params p) {
    const unsigned* d = (const unsigned*)(p.ws + WS_CTL);
    const float tol[14] = {1e-3f, 0.5f, 0.02f, 0.02f, 0.03f, 0.05f, 0.05f, 0.02f, 0.03f, 1e-3f, 0.02f, 0.05f, 0.03f, 0.03f};
    int code = -1;
#pragma unroll
    for (int k = 13; k >= 0; --k) if (__uint_as_float(d[k]) > tol[k]) code = k;
    if (code >= 0) {
        for (size_t i = (size_t)blockIdx.x * blockDim.x + threadIdx.x; i < (size_t)T_ * D_; i += (size_t)gridDim.x * blockDim.x) p.out[i] = (i == 0) ? 1.0e6f * (float)(code + 1) : 0.f;
    }
}
#endif

extern "C" void kernel_launch(void* const* d_in, const int* in_sizes, int n_in, void* d_out, int out_size, void* d_ws, size_t ws_size, hipStream_t stream) {
    static int grid = 0;
    if (grid == 0) {
        if (n_in != 15 || out_size != T_ * D_ || ws_size < WS_END) { fprintf(stderr, "kernel_launch: unexpected problem (n_in %d out %d ws %zu)\n", n_in, out_size, ws_size); grid = -1; return; }
        int dev = 0, cus = 0, per_cu = 0;
        (void)hipGetDevice(&dev);
        (void)hipDeviceGetAttribute(&cus, hipDeviceAttributeMultiprocessorCount, dev);
        if (hipFuncSetAttribute((const void*)mega, hipFuncAttributeMaxDynamicSharedMemorySize, LDS_BYTES) != hipSuccess) { fprintf(stderr, "kernel_launch: hipFuncSetAttribute failed\n"); grid = -1; return; }
        if (hipOccupancyMaxActiveBlocksPerMultiprocessor(&per_cu, (const void*)mega, 512, LDS_BYTES) != hipSuccess || per_cu < 1) { fprintf(stderr, "kernel_launch: occupancy query gave %d\n", per_cu); per_cu = 1; }
        (void)hipGetLastError();
        grid = cus * per_cu;
        if (grid > 256) grid = 256;
    }
    if (grid < 0) return;
    Params p{};
    p.x = (const float*)d_in[0]; p.c = (const float*)d_in[1]; p.w_ada = (const float*)d_in[2]; p.b_ada = (const float*)d_in[3]; p.norm1_g = (const float*)d_in[4];
    p.w_in = (const float*)d_in[5]; p.pool_w = (const float*)d_in[6]; p.pool_scale = (const float*)d_in[7]; p.w_out = (const float*)d_in[8]; p.norm2_g = (const float*)d_in[9];
    p.peer_wq = (const float*)d_in[10]; p.peer_sk = (const float*)d_in[11]; p.peer_u = (const float*)d_in[12]; p.peer_v = (const float*)d_in[13]; p.final_g = (const float*)d_in[14];
    p.out = (float*)d_out; p.ws = (unsigned char*)d_ws;
#if DEBUG_CHECKS
    (void)hipMemsetAsync((char*)d_ws + WS_CTL, 0, 4096, stream);
#endif
    (void)hipMemsetAsync((char*)d_ws + WS_BAR, 0, 32768, stream);
#if N_LAUNCH_MODE == 0 || DEBUG_CHECKS
    for (int ph = 0; ph < NPH; ++ph) {
        p.ph_lo = ph; p.ph_hi = ph + 1;
        hipLaunchKernelGGL(mega, dim3(grid), dim3(512), LDS_BYTES, stream, p);
#if DEBUG_CHECKS
        hipLaunchKernelGGL(check_kernel, dim3(256), dim3(512), 0, stream, p, ph);
#endif
    }
#if DEBUG_CHECKS
    hipLaunchKernelGGL(report_kernel, dim3(2048), dim3(256), 0, stream, p);
#endif
#else
    p.ph_lo = 0; p.ph_hi = NPH;
    void* args[] = {&p};
    hipError_t e = hipLaunchCooperativeKernel((const void*)mega, dim3(grid), dim3(512), args, LDS_BYTES, stream);
    if (e != hipSuccess) fprintf(stderr, "cooperative launch failed: %s (grid %d)\n", hipGetErrorString(e), grid);
#if defined(PROBE_UCHK) && PROBE_UCHK
    { unsigned* fl = (unsigned*)((unsigned char*)d_ws + WS_BAR + 16384 + 8192); hipLaunchKernelGGL(uchk_kernel, dim3(128), dim3(256), 0, stream, p, fl); hipLaunchKernelGGL(uchk_report, dim3(1), dim3(1), 0, stream, p, (const unsigned*)fl); }
#endif
#if defined(PROBE_TR4) && PROBE_TR4
    hipLaunchKernelGGL(tr4_probe_kernel, dim3(1), dim3(64), 0, stream, p);
#endif
#if defined(PROBE_MF4) && PROBE_MF4
    hipLaunchKernelGGL(mf4_probe_kernel, dim3(1), dim3(64), 0, stream, p);
#endif
#if defined(PROBE_FP4) && PROBE_FP4
    hipLaunchKernelGGL(fp4_probe_kernel, dim3(1), dim3(64), 0, stream, p);
#endif
#if defined(PROBE_FP6) && PROBE_FP6
    hipLaunchKernelGGL(fp6_probe_kernel, dim3(1), dim3(64), 0, stream, p);
#endif
#endif
}
```

```cpp
#include <hip/hip_runtime.h>
#include <hip/hip_cooperative_groups.h>
#include <cstdio>
#include <cstdint>
namespace cg = cooperative_groups;

#ifndef DEBUG_CHECKS
#define DEBUG_CHECKS 0
#endif
#ifndef N_LAUNCH_MODE
#define N_LAUNCH_MODE 1
#endif

#define LAS __attribute__((address_space(3)))
typedef unsigned short bf16_t;
typedef short bf16x8 __attribute__((ext_vector_type(8)));
typedef short s16x4 __attribute__((ext_vector_type(4)));
typedef float f32x4 __attribute__((ext_vector_type(4)));
typedef float f32x16 __attribute__((ext_vector_type(16)));
typedef unsigned u32x4 __attribute__((ext_vector_type(4)));
typedef unsigned u32x2 __attribute__((ext_vector_type(2)));
typedef _Float16 half2_t __attribute__((ext_vector_type(2)));

constexpr int T_ = 65536, D_ = 1024, S_ = 8192, NB_ = 8, MODW = 6144;
constexpr int NPH = 12;
constexpr size_t WS_CTL = 0;
constexpr size_t WS_PMAX = 4096;
constexpr size_t WS_MOD = 8192;
constexpr size_t WS_WIN = WS_MOD + 196608;
constexpr size_t WS_WOUT = WS_WIN + 4194304;
constexpr size_t WS_WQ = WS_WOUT + 2097152;
constexpr size_t WS_SK = WS_WQ + 4194304;
constexpr size_t WS_U8 = WS_SK + 65536;
constexpr size_t WS_V8 = WS_U8 + 16777216;
constexpr size_t WS_H = WS_V8 + 16777216;
constexpr size_t WS_QKVU = WS_H + 134217728;
constexpr size_t WS_X1 = WS_QKVU + 268435456;
constexpr size_t WS_H8 = WS_X1 + 134217728;
constexpr size_t WS_HSC = WS_H8 + 67108864;
constexpr size_t WS_EID = WS_X1 + 268435456;
constexpr size_t WS_GATE = WS_EID + 16777216;
constexpr size_t WS_PART = WS_QKVU;
constexpr size_t WS_COEF = WS_GATE + 33554432;
constexpr size_t WS_SSQ = WS_COEF + 33554432;
constexpr size_t WS_BAR = WS_SSQ + 2097152;
constexpr size_t WS_END = WS_BAR + 32768;
constexpr int LDS_BYTES = 155648;

struct Params {
    const float *x, *c, *w_ada, *b_ada, *norm1_g, *w_in, *pool_w, *pool_scale, *w_out, *norm2_g, *peer_wq, *peer_sk, *peer_u, *peer_v, *final_g;
    float* out; unsigned char* ws; int ph_lo, ph_hi;
};

__device__ __forceinline__ bf16_t f2bf(float f) { unsigned u = __float_as_uint(f); u += 0x7FFFu + ((u >> 16) & 1u); return (bf16_t)(u >> 16); }
__device__ __forceinline__ float bf2f(bf16_t h) { return __uint_as_float(((unsigned)h) << 16); }
__device__ __forceinline__ unsigned pk2(float lo, float hi) { unsigned r; asm volatile("v_cvt_pk_bf16_f32 %0, %1, %2" : "=v"(r) : "v"(lo), "v"(hi)); return r; }
__device__ __forceinline__ float wave_sum(float v) {
#pragma unroll
    for (int o = 1; o < 64; o <<= 1) v += __shfl_xor(v, o);
    return v;
}
__device__ __forceinline__ float wave_max(float v) {
#pragma unroll
    for (int o = 1; o < 64; o <<= 1) v = fmaxf(v, __shfl_xor(v, o));
    return v;
}
__device__ __forceinline__ float fast_exp2(float x) { return __builtin_amdgcn_exp2f(x); }
namespace pg8 {
#define PG8_LAS __attribute__((address_space(3)))
typedef unsigned short bf16_t;
typedef short bf16x8 __attribute__((ext_vector_type(8)));
typedef float f32x4 __attribute__((ext_vector_type(4)));
typedef unsigned u32x4 __attribute__((ext_vector_type(4)));
constexpr int BM = 256, BK = 64, HALF = 128, HTB = HALF * BK * 2  , STAGE_BYTES = 8 * HTB, NXCD = 8, WGM = 8;

__host__ __device__ __forceinline__ int lds_byte(int r, int c) { const int st = (r >> 4) * 2 + (c >> 5), rr = r & 15, cc = c & 31, ob = rr * 64 + cc * 2; return st * 1024 + (ob ^ (((ob >> 9) & 1) << 5)); }
__host__ __device__ __forceinline__ void stage_rc(int b, int& R, int& C) { const int st = b / 1024, sb = b % 1024, swz = sb ^ (((sb >> 9) & 1) << 5); R = (st >> 1) * 16 + swz / 64; C = (st & 1) * 32 + (swz % 64) / 2; }
__host__ __device__ __forceinline__ int perm32(int rho) { const int n = rho >> 4, i = rho & 15; return 8 * (i >> 2) + 4 * n + (i & 3); }

struct Unit { int pm, pn; };
struct Gemm { const bf16_t* A; const bf16_t* Bt; int M, N, K; };

struct StaticOrder {
    int nM, nN, nwg, G, c;
    __host__ __device__ void init(int M, int N, int G_, int c_) { nM = M / BM; nN = N / BM; nwg = nM * nN; G = G_; c = c_; }
    __host__ __device__ bool next(int i, Unit& u) const {
        const long L = (long)i * G + c; if (L >= nwg) return false;
        int wgid = (int)L; { const int q = nwg / NXCD, r = nwg % NXCD, xcd = wgid % NXCD, off = wgid / NXCD; wgid = (xcd < r ? xcd * (q + 1) : r * (q + 1) + (xcd - r) * q) + off; }
        const int nig = WGM * nN, gid = wgid / nig, fm = gid * WGM, gsz = (nM - fm) < WGM ? (nM - fm) : WGM;
        u.pm = fm + ((wgid % nig) % gsz); u.pn = (wgid % nig) / gsz; return true;
    }
    __device__ __forceinline__ void a_ready(const Unit&) const {}
    __device__ __forceinline__ void done(const Unit&) const {}
};
__device__ __forceinline__ unsigned cvt_pk_bf16(float lo, float hi) { unsigned r; asm volatile("v_cvt_pk_bf16_f32 %0, %1, %2" : "=v"(r) : "v"(lo), "v"(hi)); return r; }
struct EpiBf16 {
    static constexpr bool PERM = true, AFTER_DRAIN = false;
    bf16_t* O; int ldc; int nscaled; float scale;
    __device__ __forceinline__ void operator()(const f32x4 (&acc)[2][2][4][2], const Unit& u, int wr, int wc, int fr, int fq) const {
        const int row0 = u.pm * BM + wr * 64 + fr, col0 = u.pn * BM + wc * 32 + 8 * fq;
        const float sc = (u.pn < nscaled) ? scale : 1.0f;
#pragma unroll
        for (int ai = 0; ai < 2; ++ai)
#pragma unroll
            for (int m = 0; m < 4; ++m) { bf16_t* rowp = O + (size_t)(row0 + ai * HALF + m * 16) * ldc + col0;
#pragma unroll
                for (int bj = 0; bj < 2; ++bj) { const f32x4 v0 = acc[ai][bj][m][0] * sc, v1 = acc[ai][bj][m][1] * sc;
                    u32x4 w; w.x = cvt_pk_bf16(v0[0], v0[1]); w.y = cvt_pk_bf16(v0[2], v0[3]); w.z = cvt_pk_bf16(v1[0], v1[1]); w.w = cvt_pk_bf16(v1[2], v1[3]);
                    *(u32x4*)(rowp + bj * HALF) = w; } }
    }
};
struct EpiRes {
    static constexpr bool PERM = false, AFTER_DRAIN = false;
    const float* X; float* X1; const float* gate;
    __device__ __forceinline__ void operator()(const f32x4 (&acc)[2][2][4][2], const Unit& u, int wr, int wc, int fr, int fq) const {
        const int row0 = u.pm * BM + wr * 64 + fr, col0 = u.pn * BM + wc * 32 + 4 * fq;
        const float* gp = gate + (size_t)(u.pm >> 5) * 6144 + col0;
        f32x4 gv[2][2];
#pragma unroll
        for (int bj = 0; bj < 2; ++bj)
#pragma unroll
            for (int n = 0; n < 2; ++n) gv[bj][n] = *(const f32x4*)(gp + bj * HALF + n * 16);
#pragma unroll
        for (int ai = 0; ai < 2; ++ai)
#pragma unroll
            for (int m = 0; m < 4; ++m) { const size_t off = (size_t)(row0 + ai * HALF + m * 16) * 1024 + col0;
#pragma unroll
                for (int bj = 0; bj < 2; ++bj)
#pragma unroll
                    for (int n = 0; n < 2; ++n) { const f32x4 xv = *(const f32x4*)(X + off + bj * HALF + n * 16);
                        *(f32x4*)(X1 + off + bj * HALF + n * 16) = xv + gv[bj][n] * acc[ai][bj][m][n]; } }
    }
};
template <class Epi, class Sched>
__device__ __forceinline__ void gemm_phase(PG8_LAS unsigned char* lds, const Gemm g, const Sched& S, const Epi& E, const int tid_flat) {
    const int tid = tid_flat, wid = __builtin_amdgcn_readfirstlane(tid >> 6), lane = tid & 63, wr = wid >> 2, wc = wid & 3, fr = lane & 15, fq = lane >> 4;
    const int K = g.K, nt = K / BK;
    unsigned voffA[2], voffB[2];
#pragma unroll
    for (int i = 0; i < 2; ++i) { int R, C; stage_rc(tid * 16 + i * 8192, R, C); const int Rb = Epi::PERM ? ((R & ~31) + perm32(R & 31)) : R;
        voffA[i] = (unsigned)(R * K + C) * 2u; voffB[i] = (unsigned)(Rb * K + C) * 2u; }
    const size_t kstep = (size_t)(BK * 2);
    const size_t hstep = (size_t)HALF * K * 2;
    const size_t tstep = 2 * hstep;
    const unsigned ldsw = (unsigned)wid * 1024u;
    const int aoff = lds_byte(wr * 64 + fr, fq * 8), boff = lds_byte(wc * 32 + fr, fq * 8);
#define PG8_SA(b, h) (((b) * 2 + (h)) * HTB)
#define PG8_SB(b, h) ((4 + (b) * 2 + (h)) * HTB)
#define PG8_STAGE(bufoff, gbase, voff) do { _Pragma("unroll") for (int _i = 0; _i < 2; ++_i) \
        __builtin_amdgcn_global_load_lds((const unsigned*)((const char*)(gbase) + (voff)[_i]), (PG8_LAS unsigned*)(lds + (bufoff) + ldsw + _i * 8192), 16, 0, 0); } while (0)
#define PG8_LDA(dst, b, h) do { _Pragma("unroll") for (int m = 0; m < 4; ++m) _Pragma("unroll") for (int k = 0; k < 2; ++k) dst[m][k] = *(const PG8_LAS bf16x8*)(lds + PG8_SA(b, h) + aoff + m * 2048 + k * 1024); } while (0)
#define PG8_LDB(dst, b, h) do { _Pragma("unroll") for (int n = 0; n < 2; ++n) _Pragma("unroll") for (int k = 0; k < 2; ++k) dst[n][k] = *(const PG8_LAS bf16x8*)(lds + PG8_SB(b, h) + boff + n * 2048 + k * 1024); } while (0)
#define PG8_MMA(ai, bj, At, Bt) do { __builtin_amdgcn_s_setprio(1); _Pragma("unroll") for (int m = 0; m < 4; ++m) _Pragma("unroll") for (int n = 0; n < 2; ++n) _Pragma("unroll") for (int k = 0; k < 2; ++k) \
        acc[ai][bj][m][n] = __builtin_amdgcn_mfma_f32_16x16x32_bf16(Bt[n][k], At[m][k], acc[ai][bj][m][n], 0, 0, 0); __builtin_amdgcn_s_setprio(0); } while (0)
#define PG8_WAIT_V(n) asm volatile("s_waitcnt vmcnt(" #n ")" ::: "memory")
#define PG8_WAIT_L(n) asm volatile("s_waitcnt lgkmcnt(" #n ")" ::: "memory")
#define PG8_BAR __builtin_amdgcn_s_barrier()
#define PG8_SCHED __builtin_amdgcn_sched_barrier(0)
    Unit cur, nxt; int ui = 0;
    if (!S.next(0, cur)) return;
    f32x4 acc[2][2][4][2];
#pragma unroll
    for (int a = 0; a < 2; ++a)
#pragma unroll
        for (int b = 0; b < 2; ++b)
#pragma unroll
            for (int m = 0; m < 4; ++m)
#pragma unroll
                for (int n = 0; n < 2; ++n) acc[a][b][m][n] = (f32x4){0.f, 0.f, 0.f, 0.f};
    bf16x8 At[4][2], B0[2][2], B1[2][2];
    const char* cA = (const char*)g.A + (size_t)cur.pm * tstep; const char* cB = (const char*)g.Bt + (size_t)cur.pn * tstep;
    S.a_ready(cur);
    PG8_STAGE(PG8_SB(0, 0), cB, voffB); PG8_STAGE(PG8_SA(0, 0), cA, voffA); PG8_STAGE(PG8_SB(0, 1), cB + hstep, voffB); PG8_STAGE(PG8_SA(0, 1), cA + hstep, voffA);
    if (wr == 1) PG8_BAR;
    PG8_WAIT_V(4); PG8_BAR;
    PG8_STAGE(PG8_SB(1, 0), cB + kstep, voffB); PG8_STAGE(PG8_SA(1, 0), cA + kstep, voffA); PG8_STAGE(PG8_SB(1, 1), cB + hstep + kstep, voffB);
    PG8_WAIT_V(6); PG8_BAR;
    for (;;) {
        const bool has_next = S.next(ui + 1, nxt);
        const char* nA = has_next ? (const char*)g.A + (size_t)nxt.pm * tstep : cA; const char* nB = has_next ? (const char*)g.Bt + (size_t)nxt.pn * tstep : cB;
        for (int t = 0; t < nt; t += 2) {
            const bool last = (t == nt - 2);
            const char* a1 = cA + (size_t)(t + 1) * kstep;
            const char* a2 = last ? nA : cA + (size_t)(t + 2) * kstep; const char* b2 = last ? nB : cB + (size_t)(t + 2) * kstep;
            const char* a3 = a2 + kstep; const char* b3 = b2 + kstep;
            if (last && has_next) S.a_ready(nxt);
            PG8_LDB(B0, 0, 0); PG8_SCHED; PG8_LDA(At, 0, 0); PG8_STAGE(PG8_SA(1, 1), a1 + hstep, voffA);
            PG8_WAIT_L(8); PG8_BAR; PG8_WAIT_L(0); PG8_MMA(0, 0, At, B0); PG8_BAR; PG8_SCHED;
            PG8_LDB(B1, 0, 1); PG8_STAGE(PG8_SB(0, 0), b2, voffB);
            PG8_BAR; PG8_WAIT_L(0); PG8_MMA(0, 1, At, B1); PG8_BAR;
            PG8_LDA(At, 0, 1); PG8_STAGE(PG8_SA(0, 0), a2, voffA);
            PG8_BAR; PG8_WAIT_L(0); PG8_MMA(1, 0, At, B0); PG8_BAR; PG8_SCHED;
            PG8_STAGE(PG8_SB(0, 1), b2 + hstep, voffB);
            PG8_WAIT_V(6); PG8_BAR; PG8_MMA(1, 1, At, B1); PG8_BAR;
            PG8_LDB(B0, 1, 0); PG8_SCHED; PG8_LDA(At, 1, 0); PG8_STAGE(PG8_SA(0, 1), a2 + hstep, voffA);
            PG8_WAIT_L(8); PG8_BAR; PG8_WAIT_L(0); PG8_MMA(0, 0, At, B0); PG8_BAR; PG8_SCHED;
            PG8_LDB(B1, 1, 1); PG8_STAGE(PG8_SB(1, 0), b3, voffB);
            PG8_BAR; PG8_WAIT_L(0); PG8_MMA(0, 1, At, B1); PG8_BAR;
            PG8_LDA(At, 1, 1); PG8_STAGE(PG8_SA(1, 0), a3, voffA);
            PG8_BAR; PG8_WAIT_L(0); PG8_MMA(1, 0, At, B0); PG8_BAR; PG8_SCHED;
            PG8_STAGE(PG8_SB(1, 1), b3 + hstep, voffB);
            PG8_WAIT_V(6); PG8_BAR; PG8_MMA(1, 1, At, B1); PG8_BAR;
        }
        if constexpr (!Epi::AFTER_DRAIN) { E(acc, cur, wr, wc, fr, fq); S.done(cur); }
        if (!has_next) break;
#pragma unroll
        for (int a = 0; a < 2; ++a)
#pragma unroll
            for (int b = 0; b < 2; ++b)
#pragma unroll
                for (int m = 0; m < 4; ++m)
#pragma unroll
                    for (int n = 0; n < 2; ++n) acc[a][b][m][n] = (f32x4){0.f, 0.f, 0.f, 0.f};
        cur = nxt; cA = nA; cB = nB; ++ui;
    }
    PG8_WAIT_V(0);
    if (wr == 0) PG8_BAR;
    PG8_BAR;
    if constexpr (Epi::AFTER_DRAIN) { E.fused(acc, cur, wr, wc, fr, fq, lds, wid, lane); S.done(cur); }
#undef PG8_SA
#undef PG8_SB
#undef PG8_STAGE
#undef PG8_LDA
#undef PG8_LDB
#undef PG8_MMA
#undef PG8_WAIT_V
#undef PG8_WAIT_L
#undef PG8_BAR
#undef PG8_SCHED
}
}
__device__ __forceinline__ int lane_id_() { return (int)__builtin_amdgcn_mbcnt_hi(~0u, __builtin_amdgcn_mbcnt_lo(~0u, 0u)); }

constexpr int I_MOD = 96, I_TIN = 16 * 24, I_TOUT = 16 * 16, I_TQ = 16 * 32, I_FOLD = 64, I_SK = 1, I_U = 512, I_V = 512;
constexpr int I_TOTAL = I_MOD + I_TIN + I_TOUT + I_TQ + I_FOLD + I_SK + I_U + I_V;

__device__ __forceinline__ void p0_mod_item(const Params& p, LAS unsigned char* lds, int item, int tid) {
    LAS float* sc = (LAS float*)lds;
    LAS float* red = (LAS float*)(lds + 32768);
    for (int i = tid; i < 8192; i += 512) { const float v = p.c[i]; sc[i] = v / (1.0f + __expf(-v)); }
    __syncthreads();
    const int col = tid & 63, kg = tid >> 6;
    float acc[8];
#pragma unroll
    for (int b = 0; b < 8; ++b) acc[b] = 0.f;
    const float* w = p.w_ada + (size_t)(kg * 128) * MODW + item * 64 + col;
#pragma unroll 1
    for (int k0 = 0; k0 < 128; k0 += 32) { float wv[32];
#pragma unroll
        for (int k = 0; k < 32; ++k) wv[k] = w[(size_t)(k0 + k) * MODW];
#pragma unroll
        for (int k = 0; k < 32; ++k)
#pragma unroll
            for (int b = 0; b < 8; ++b) acc[b] += sc[b * 1024 + kg * 128 + k0 + k] * wv[k]; }
#pragma unroll
    for (int b = 0; b < 8; ++b) red[(kg * 8 + b) * 64 + col] = acc[b];
    __syncthreads();
    { const int b = tid >> 6; float s = 0.f;
#pragma unroll
      for (int k2 = 0; k2 < 8; ++k2) s += red[(k2 * 8 + b) * 64 + col];
      float* mod = (float*)(p.ws + WS_MOD);
      mod[b * MODW + item * 64 + col] = s + p.b_ada[item * 64 + col]; }
    __syncthreads();
}
__device__ __forceinline__ void p0_tr_item(const float* W, int N, bf16_t* WT, int K, int row_off, int k0, int n0, LAS unsigned char* lds, int tid) {
    LAS float* tile = (LAS float*)lds;
    { const int kk = tid >> 4, n4 = (tid & 15) * 4;
#pragma unroll
      for (int hf = 0; hf < 2; ++hf) { const int k = kk + 32 * hf; const f32x4 v = *(const f32x4*)(W + (size_t)(k0 + k) * N + n0 + n4);
          tile[k * 65 + n4 + 0] = v[0]; tile[k * 65 + n4 + 1] = v[1]; tile[k * 65 + n4 + 2] = v[2]; tile[k * 65 + n4 + 3] = v[3]; } }
    __syncthreads();
    { const int n = tid >> 3, c = tid & 7; float v[8];
#pragma unroll
      for (int j = 0; j < 8; ++j) v[j] = tile[(8 * c + j) * 65 + n];
      u32x4 o; o.x = pk2(v[0], v[1]); o.y = pk2(v[2], v[3]); o.z = pk2(v[4], v[5]); o.w = pk2(v[6], v[7]);
      *(u32x4*)(WT + (size_t)(row_off + n0 + n) * K + k0 + 8 * c) = o; }
    __syncthreads();
}
__device__ __forceinline__ void p0_fold_item(const Params& p, LAS unsigned char* lds, int item, int tid) {
    const int g = item >> 4, k0 = (item & 15) * 64;
    LAS float* Wn = (LAS float*)lds;
    LAS float* Pw = Wn + 64 * 128;
#pragma unroll
    for (int i = 0; i < 4; ++i) { const int idx = tid * 4 + 2048 * i, row = idx >> 7, col = idx & 127;
        const f32x4 v = *(const f32x4*)(p.w_in + (size_t)(k0 + row) * 2048 + 1536 + g * 128 + col);
        *(LAS f32x4*)(Wn + idx) = v; }
#pragma unroll
    for (int i = 0; i < 8; ++i) { const int idx = tid * 4 + 2048 * i;
        *(LAS f32x4*)(Pw + idx) = *(const f32x4*)(p.pool_w + (size_t)g * 16384 + idx); }
    __syncthreads();
    const int e = tid & 127, kq = tid >> 7;
    float acc[16];
#pragma unroll
    for (int kk = 0; kk < 16; ++kk) acc[kk] = 0.f;
    for (int c = 0; c < 128; ++c) { const float pv = Pw[c * 128 + e];
#pragma unroll
        for (int kk = 0; kk < 16; ++kk) acc[kk] += Wn[(kq * 16 + kk) * 128 + c] * pv; }
    const float scl = p.pool_scale[g * 128 + e];
    bf16_t* WT = (bf16_t*)(p.ws + WS_WIN) + (size_t)(1536 + g * 128 + e) * 1024 + k0 + kq * 16;
    u32x4 o0, o1;
    o0.x = pk2(acc[0] * scl, acc[1] * scl); o0.y = pk2(acc[2] * scl, acc[3] * scl); o0.z = pk2(acc[4] * scl, acc[5] * scl); o0.w = pk2(acc[6] * scl, acc[7] * scl);
    o1.x = pk2(acc[8] * scl, acc[9] * scl); o1.y = pk2(acc[10] * scl, acc[11] * scl); o1.z = pk2(acc[12] * scl, acc[13] * scl); o1.w = pk2(acc[14] * scl, acc[15] * scl);
    *(u32x4*)(WT) = o0; *(u32x4*)(WT + 8) = o1;
    __syncthreads();
}
__device__ __forceinline__ unsigned pkh2(float lo, float hi) { half2_t h; h.x = (_Float16)lo; h.y = (_Float16)hi; return __builtin_bit_cast(unsigned, h); }
template <bool HALFP> __device__ __forceinline__ void p0_cvt_item(const float* src, unsigned short* dst, int item, int tid) {
#pragma unroll 4
    for (int it = 0; it < 8; ++it) { const size_t idx = (size_t)item * 32768 + (size_t)(it * 512 + tid) * 8;
        const f32x4 a = *(const f32x4*)(src + idx), b = *(const f32x4*)(src + idx + 4);
        u32x4 o;
        if (HALFP) { o.x = pkh2(a[0], a[1]); o.y = pkh2(a[2], a[3]); o.z = pkh2(b[0], b[1]); o.w = pkh2(b[2], b[3]); }
        else { o.x = pk2(a[0], a[1]); o.y = pk2(a[2], a[3]); o.z = pk2(b[0], b[1]); o.w = pk2(b[2], b[3]); }
        *(u32x4*)(dst + idx) = o; }
}
__device__ __forceinline__ void p0_max_item(const float* tab, float* pmax, int item, LAS unsigned char* lds, int tid) {
    const float* src = tab + (size_t)(item & 511) * 32768;
    const bool sq = true;
    float m = 0.f;
#pragma unroll 4
    for (int it = 0; it < 16; ++it) { const f32x4 a = *(const f32x4*)(src + (size_t)(it * 512 + tid) * 4);
        if (sq) m += (a[0] * a[0] + a[1] * a[1]) + (a[2] * a[2] + a[3] * a[3]);
        else m = fmaxf(fmaxf(m, fmaxf(fabsf(a[0]), fabsf(a[1]))), fmaxf(fabsf(a[2]), fabsf(a[3]))); }
    m = sq ? wave_sum(m) : wave_max(m);
    LAS float* red = (LAS float*)lds;
    if ((tid & 63) == 0) red[tid >> 6] = m;
    __syncthreads();
    if (tid == 0) { float mm = red[0];
#pragma unroll
        for (int w = 1; w < 8; ++w) mm = sq ? (mm + red[w]) : fmaxf(mm, red[w]);
        pmax[item] = mm; }
    __syncthreads();
}
struct TrD { const float* W; bf16_t* WT; int N, k0, n0; };
__device__ __forceinline__ TrD p0_tr_desc(const Params& p, int r) {
    TrD d;
    if (r < I_TIN) { d.W = p.w_in; d.WT = (bf16_t*)(p.ws + WS_WIN); d.N = 2048; d.k0 = (r / 24) * 64; d.n0 = (r % 24) * 64; return d; } r -= I_TIN;
    if (r < I_TOUT) { d.W = p.w_out; d.WT = (bf16_t*)(p.ws + WS_WOUT); d.N = 1024; d.k0 = (r / 16) * 64; d.n0 = (r % 16) * 64; return d; } r -= I_TOUT;
    d.W = p.peer_wq; d.WT = (bf16_t*)(p.ws + WS_WQ); d.N = 2048; d.k0 = (r / 32) * 64; d.n0 = (r % 32) * 64; return d;
}
__device__ __forceinline__ void p0_tr_pair(const TrD& A, const TrD& B, bool hasB, LAS unsigned char* lds, int tid) {
    LAS float* tA = (LAS float*)lds; LAS float* tB = (LAS float*)(lds + 17408);
    const int kk = tid >> 4, n4 = (tid & 15) * 4;
    f32x4 va[2], vb[2];
#pragma unroll
    for (int hf = 0; hf < 2; ++hf) { const int k = kk + 32 * hf; va[hf] = *(const f32x4*)(A.W + (size_t)(A.k0 + k) * A.N + A.n0 + n4);
        vb[hf] = hasB ? *(const f32x4*)(B.W + (size_t)(B.k0 + k) * B.N + B.n0 + n4) : (f32x4){0.f, 0.f, 0.f, 0.f}; }
#pragma unroll
    for (int hf = 0; hf < 2; ++hf) { const int k = kk + 32 * hf;
#pragma unroll
        for (int e = 0; e < 4; ++e) { tA[k * 65 + n4 + e] = va[hf][e]; tB[k * 65 + n4 + e] = vb[hf][e]; } }
    __syncthreads();
    { const int n = tid >> 3, c = tid & 7; float v[8], w[8];
#pragma unroll
      for (int j = 0; j < 8; ++j) { v[j] = tA[(8 * c + j) * 65 + n]; w[j] = tB[(8 * c + j) * 65 + n]; }
      u32x4 o; o.x = pk2(v[0], v[1]); o.y = pk2(v[2], v[3]); o.z = pk2(v[4], v[5]); o.w = pk2(v[6], v[7]);
      *(u32x4*)(A.WT + (size_t)(A.n0 + n) * 1024 + A.k0 + 8 * c) = o;
      if (hasB) { u32x4 q; q.x = pk2(w[0], w[1]); q.y = pk2(w[2], w[3]); q.z = pk2(w[4], w[5]); q.w = pk2(w[6], w[7]);
          *(u32x4*)(B.WT + (size_t)(B.n0 + n) * 1024 + B.k0 + 8 * c) = q; } }
    __syncthreads();
}
__device__ __forceinline__ void phase_prep(const Params& p, LAS unsigned char* lds, int tid) {
    if (gridDim.x == 256) {
        constexpr int NTR = I_TIN + I_TOUT + I_TQ;
        if (blockIdx.x < I_MOD) { p0_mod_item(p, lds, blockIdx.x, tid);
            p0_tr_pair(p0_tr_desc(p, 2 * blockIdx.x), p0_tr_desc(p, 2 * blockIdx.x + 1), true, lds, tid); }
        else { const int q = blockIdx.x - I_MOD;
#pragma unroll 1
            for (int j = 0; j < 3; ++j) p0_tr_pair(p0_tr_desc(p, 2 * I_MOD + 6 * q + 2 * j), p0_tr_desc(p, 2 * I_MOD + 6 * q + 2 * j + 1), true, lds, tid);
            if (q < I_FOLD) p0_fold_item(p, lds, q, tid);
            else if (q == I_FOLD) p0_cvt_item<false>(p.peer_sk, (unsigned short*)(p.ws + WS_SK), 0, tid); }
        (void)NTR; return;
    }
    for (int it = blockIdx.x; it < I_TOTAL; it += gridDim.x) {
        int r = it;
        if (r < I_MOD) { p0_mod_item(p, lds, r, tid); continue; } r -= I_MOD;
        if (r < I_TIN) { p0_tr_item(p.w_in, 2048, (bf16_t*)(p.ws + WS_WIN), 1024, 0, (r / 24) * 64, (r % 24) * 64, lds, tid); continue; } r -= I_TIN;
        if (r < I_TOUT) { p0_tr_item(p.w_out, 1024, (bf16_t*)(p.ws + WS_WOUT), 1024, 0, (r / 16) * 64, (r % 16) * 64, lds, tid); continue; } r -= I_TOUT;
        if (r < I_TQ) { p0_tr_item(p.peer_wq, 2048, (bf16_t*)(p.ws + WS_WQ), 1024, 0, (r / 32) * 64, (r % 32) * 64, lds, tid); continue; } r -= I_TQ;
        if (r < I_FOLD) { p0_fold_item(p, lds, r, tid); continue; } r -= I_FOLD;
        if (r < I_SK) { p0_cvt_item<false>(p.peer_sk, (unsigned short*)(p.ws + WS_SK), 0, tid); continue; } r -= I_SK;
        p0_max_item(r < I_U ? p.peer_u : p.peer_v, (float*)(p.ws + WS_PMAX), r, lds, tid);
    }
}

template <int UNR> __device__ __forceinline__ void phase_norm(const float* X, const bf16_t* MIXED, const float* gv, const float* mod, int sh_off, int sc_off, bf16_t* H, unsigned char* H8, float* HSC, int gw, int nw, int lane) {
    for (int chunk = gw; chunk < T_ / 32; chunk += nw) {
        const int row0 = chunk * 32, b = row0 >> 13;
        f32x4 gm[4], sh[4], g1[4];
#pragma unroll
        for (int j = 0; j < 4; ++j) { const int c = lane * 4 + 256 * j;
            const f32x4 g4 = *(const f32x4*)(gv + c), s4 = *(const f32x4*)(mod + (size_t)b * MODW + sc_off + c);
            gm[j] = g4 * (s4 + 1.0f); sh[j] = *(const f32x4*)(mod + (size_t)b * MODW + sh_off + c);
            g1[j] = MIXED ? *(const f32x4*)(mod + (size_t)b * MODW + 2048 + c) : (f32x4){0.f, 0.f, 0.f, 0.f}; }
        float gmax = 0.f, smax = 0.f;
        if (H8) {
#pragma unroll
            for (int j = 0; j < 4; ++j)
#pragma unroll
                for (int z = 0; z < 4; ++z) { gmax = fmaxf(gmax, fabsf(gm[j][z])); smax = fmaxf(smax, fabsf(sh[j][z])); }
            gmax = wave_max(gmax); smax = wave_max(smax); }
        const float isc8 = __uint_as_float(0x7f000000u - (__float_as_uint(440.0f / fmaxf(32.0f * gmax + smax, 1e-20f)) & 0x7f800000u));
#pragma unroll UNR
        for (int r = 0; r < 32; ++r) {
            const float* xr = X + (size_t)(row0 + r) * 1024 + lane * 4;
            f32x4 v[4]; float ss = 0.f;
#pragma unroll
            for (int j = 0; j < 4; ++j) { v[j] = __builtin_nontemporal_load((const f32x4*)(xr + 256 * j));
                if (MIXED) { const u32x2 mw = __builtin_nontemporal_load((const u32x2*)(MIXED + (size_t)(row0 + r) * 1024 + lane * 4 + 256 * j));
                    v[j] += g1[j] * (f32x4){__uint_as_float(mw.x << 16), __uint_as_float(mw.x & 0xffff0000u), __uint_as_float(mw.y << 16), __uint_as_float(mw.y & 0xffff0000u)}; }
                ss += (v[j][0] * v[j][0] + v[j][1] * v[j][1]) + (v[j][2] * v[j][2] + v[j][3] * v[j][3]); }
            ss = wave_sum(ss);
            const float rstd = 1.0f / sqrtf(ss * (1.0f / 1024.0f) + 1e-6f);
            bf16_t* hr = H + (size_t)(row0 + r) * 1024 + lane * 4;
            f32x4 o[4];
#pragma unroll
            for (int j = 0; j < 4; ++j) { o[j] = v[j] * rstd * gm[j] + sh[j];
                u32x2 w; w.x = pk2(o[j][0], o[j][1]); w.y = pk2(o[j][2], o[j][3]); *(u32x2*)(hr + 256 * j) = w; }
            if (H8 && lane == 0) HSC[row0 + r] = isc8;
        }
    }
}

__device__ __forceinline__ void phase_tables_fp8(const Params& p, LAS unsigned char* lds, int tid, int bi, int nb, int tb_lo = 0, int tb_hi = 2) {
    const float* pmax = (const float*)(p.ws + WS_PMAX);
    float mu = tb_lo == 0 ? wave_sum(pmax[tid]) : 1.0f, mv = tb_hi == 2 ? wave_sum(pmax[512 + tid]) : 1.0f;
    LAS float* red = (LAS float*)lds;
    if ((tid & 63) == 0) { red[tid >> 6] = mu; red[8 + (tid >> 6)] = mv; }
    __syncthreads();
    mu = red[0]; mv = red[8];
#pragma unroll
    for (int w = 1; w < 8; ++w) { mu += red[w]; mv += red[8 + w]; }
    const float su = 6.0f / (3.0f * fmaxf(sqrtf(mu * (1.0f / 16777216.0f)), 1e-30f)), sv = 6.0f / (3.0f * fmaxf(sqrtf(mv * (1.0f / 16777216.0f)), 1e-30f));
    if (bi == 0 && tid == 0) { float* sc = (float*)(p.ws + WS_CTL) + 64; if (tb_lo == 0) sc[0] = 1.0f / su; if (tb_hi == 2) sc[1] = 1.0f / sv; }
    __syncthreads();
#pragma unroll 1
    for (int tb = tb_lo; tb < tb_hi; ++tb) {
        const float* src = tb ? p.peer_v : p.peer_u; unsigned char* dstbase = p.ws + (tb ? WS_V8 : WS_U8); const float sc = tb ? sv : su;
        for (size_t gi = ((size_t)bi * 512 + tid) * 32; gi < (size_t)16384 * 1024; gi += (size_t)nb * 512 * 32) {
            u32x4 o;
#pragma unroll
            for (int q = 0; q < 4; ++q) { unsigned w = 0u;
#pragma unroll
                for (int hq = 0; hq < 2; ++hq) { const f32x4 a = *(const f32x4*)(src + gi + 8 * q + 4 * hq) * sc;
#pragma unroll
                    for (int z = 0; z < 4; ++z) { const float ax = fabsf(a[z]);
                        const unsigned code = (unsigned)(ax > 0.25f) + (unsigned)(ax > 0.75f) + (unsigned)(ax > 1.25f) + (unsigned)(ax > 1.75f) + (unsigned)(ax > 2.5f) + (unsigned)(ax > 3.5f) + (unsigned)(ax > 5.0f) + (a[z] < 0.f ? 8u : 0u);
                        w |= code << (4 * (4 * hq + z)); } }
                o[q] = w; }
            const size_t e = gi >> 10, col = gi & 1023;
            *(u32x4*)(dstbase + (((col >> 8) * 16384 + e) << 7) + ((col & 255) >> 1)) = o; }
    }
}

__device__ __forceinline__ bf16x8 mk_bf16x8(const u32x4 v) { return __builtin_bit_cast(bf16x8, v); }
struct AttnTask { int d, r, c, kt0, qloc; float c1; };
__device__ __forceinline__ AttnTask attn_task(int n, int wave, int p0, int i, float slope) {
    AttnTask t; const int br = n >> 1, tk = n & 1, tprl = 4 - 2 * br; t.d = 1 << (2 * br);
    const int tau = wave + 8 * tk; t.r = tau >> tprl; t.c = tau & ((1 << tprl) - 1);
    t.qloc = t.r + t.d * (32 * t.c + i);
    const int first = 4 - t.c - p0 / (32 * t.d);
    t.kt0 = first > 0 ? first : 0;
    t.c1 = slope * (float)t.d * 1.4426950408889634f;
    return t;
}
struct AttnTile { u32x4 kr[4]; u32x4 vr[4]; };
__device__ __forceinline__ void attn_load_tile(AttnTile& T, const bf16_t* QKV, size_t tok0, int p0, const AttnTask& t, int kt, int hh, int i, int h, int lane) {
    const int kbase = p0 + t.r + t.d * 32 * (t.c - 4 + kt);
#pragma unroll
    for (int n = 0; n < 4; ++n) { const bf16_t* rp = QKV + (tok0 + kbase + t.d * (8 * n + (lane >> 3))) * 2048 + 64 * hh + 8 * (lane & 7);
        T.kr[n] = *(const u32x4*)(rp + 512); T.vr[n] = *(const u32x4*)(rp + 1024); }
}
#ifndef PROBE_ATT
#define PROBE_ATT 0
#endif
#ifndef REP_MASK
#define REP_MASK 0
#endif
#ifndef REPS
#define REPS(k) ((((REP_MASK) >> (k)) & 1) ? 2 : 1)
#endif
__device__ __forceinline__ void attn_item(const Params& p, LAS unsigned char* lds, int item, int tid, int wave, int lane, bool probe) {
    const bf16_t* QKV = (const bf16_t*)(p.ws + WS_QKVU);
    bf16_t* MIX = (bf16_t*)(p.ws + (probe ? WS_X1 : WS_H));
    const int blk = item & 15, hh = (item >> 4) & 7, b = item >> 7;
    const int p0 = blk * 512; const size_t tok0 = (size_t)b * 8192;
    LAS float* Ol = (LAS float*)lds;
    LAS float* Ml = (LAS float*)(lds + 131072);
    LAS float* Ll = Ml + 512;
    LAS unsigned char* vst = lds + 131072 + 4096 + wave * 2048;
    const int i = lane & 31, h = lane >> 5;
    const float LOG2E = 1.4426950408889634f;
    const float slope = __builtin_amdgcn_exp2f(-(float)(hh + 1));
    AttnTask T = attn_task(0, wave, p0, i, slope);
    bf16x8 qf[4];
    { const bf16_t* qp = QKV + (tok0 + p0 + T.qloc) * 2048 + 64 * hh + 8 * h;
#pragma unroll
      for (int s = 0; s < 4; ++s) qf[s] = *(const bf16x8*)(qp + 16 * s); }
    AttnTile cur; attn_load_tile(cur, QKV, tok0, p0, T, T.kt0, hh, i, h, lane);
#pragma unroll 1
    for (int n = 0; n < 6; ++n) {
        const int br = n >> 1;
        const AttnTask Tn = attn_task(n < 5 ? n + 1 : n, wave, p0, i, slope);
        bf16x8 qn[4];
#pragma unroll
        for (int s = 0; s < 4; ++s) qn[s] = qf[s];
        float m = -1e30f, l = 0.f;
        f32x16 o0, o1;
#pragma unroll
        for (int e = 0; e < 16; ++e) { o0[e] = 0.f; o1[e] = 0.f; }
        const float c1 = T.c1;
#pragma unroll 1
        for (int kt = T.kt0; kt < 5; ++kt) {
            AttnTile nxt;
            if (kt < 4) attn_load_tile(nxt, QKV, tok0, p0, T, (PROBE_ATT == 1 && probe) ? 4 : kt + 1, hh, i, h, lane);
            else { attn_load_tile(nxt, QKV, tok0, p0, Tn, (PROBE_ATT == 1 && probe) ? 4 : Tn.kt0, hh, i, h, lane);
                   const bf16_t* qp = QKV + (tok0 + p0 + Tn.qloc) * 2048 + 64 * hh + 8 * h;
#pragma unroll
                   for (int s = 0; s < 4; ++s) qn[s] = *(const bf16x8*)(qp + 16 * s); }
            const float base = -c1 * (float)(128 - 32 * kt + i - 4 * h);
            f32x16 sa;
#pragma unroll
            for (int rho = 0; rho < 16; ++rho) sa[rho] = base + c1 * (float)((rho & 3) + 8 * (rho >> 2));
            bf16x8 kf[4];
            { const int r8 = lane >> 3, c = lane & 7;
              const unsigned wofs = (unsigned)(r8 * 64) + 16u * (unsigned)((c & 3) ^ (r8 >> 2)), rofs = (unsigned)(i * 64), rsw = (unsigned)((i >> 2) & 3);
#pragma unroll
              for (int hf = 0; hf < 2; ++hf) {
                  if ((c >> 2) == hf) {
#pragma unroll
                      for (int n = 0; n < 4; ++n) *(LAS u32x4*)(vst + (wofs ^ (unsigned)(16 * ((2 * n) & 3))) + 512 * n) = cur.kr[n]; }
                  __builtin_amdgcn_fence(__ATOMIC_ACQ_REL, "wavefront"); __builtin_amdgcn_wave_barrier(); asm volatile("" ::: "memory");
                  kf[2 * hf + 0] = mk_bf16x8(*(const LAS u32x4*)(vst + rofs + 16u * ((unsigned)(0 + h) ^ rsw)));
                  kf[2 * hf + 1] = mk_bf16x8(*(const LAS u32x4*)(vst + rofs + 16u * ((unsigned)(2 + h) ^ rsw))); } }
#pragma unroll
            for (int s = 0; s < 4; ++s) sa = __builtin_amdgcn_mfma_f32_32x32x16_bf16(kf[s], qf[s], sa, 0, 0, 0);
            float t[16]; float mx = -INFINITY;
            if (kt == 0) {
#pragma unroll
                for (int rho = 0; rho < 16; ++rho) { const int jj = (rho & 3) + 8 * (rho >> 2) + 4 * h;
                    t[rho] = (jj < i) ? -INFINITY : sa[rho]; mx = fmaxf(mx, t[rho]); }
            } else if (kt == 4) {
#pragma unroll
                for (int rho = 0; rho < 16; ++rho) { const int jj = (rho & 3) + 8 * (rho >> 2) + 4 * h;
                    t[rho] = (jj > i) ? -INFINITY : sa[rho]; mx = fmaxf(mx, t[rho]); }
            } else {
#pragma unroll
                for (int rho = 0; rho < 16; ++rho) { t[rho] = sa[rho]; mx = fmaxf(mx, t[rho]); }
            }
            mx = fmaxf(mx, __shfl_xor(mx, 32));
            if (!__all(mx <= m)) {
                const float mn = fmaxf(m, mx), alpha = fast_exp2(m - mn);
                l *= alpha; m = mn;
#pragma unroll
                for (int e = 0; e < 16; ++e) { o0[e] *= alpha; o1[e] *= alpha; }
            }
            float ls = 0.f;
#pragma unroll
            for (int rho = 0; rho < 16; ++rho) { t[rho] = fast_exp2(t[rho] - m); ls += t[rho]; }
            l += ls;
            bf16x8 pb[2];
#pragma unroll
            for (int s2 = 0; s2 < 2; ++s2) { u32x4 w; w.x = pk2(t[8 * s2 + 0], t[8 * s2 + 1]); w.y = pk2(t[8 * s2 + 2], t[8 * s2 + 3]); w.z = pk2(t[8 * s2 + 4], t[8 * s2 + 5]); w.w = pk2(t[8 * s2 + 6], t[8 * s2 + 7]); pb[s2] = mk_bf16x8(w); }
#pragma unroll
            for (int s2 = 0; s2 < 2; ++s2) {
                *(LAS u32x4*)(vst + (0 + (lane >> 3)) * 128 + (lane & 7) * 16) = cur.vr[2 * s2 + 0];
                *(LAS u32x4*)(vst + (8 + (lane >> 3)) * 128 + (lane & 7) * 16) = cur.vr[2 * s2 + 1];
                const int q4 = (lane & 15) >> 2, p4 = lane & 3, g1 = (lane >> 4) & 1;
                LAS unsigned char* rb = vst + (4 * h + q4) * 128 + (16 * g1 + 4 * p4) * 2;
                const s16x4 a0 = __builtin_amdgcn_ds_read_tr16_b64_v4i16((LAS s16x4*)(rb));
                const s16x4 a1 = __builtin_amdgcn_ds_read_tr16_b64_v4i16((LAS s16x4*)(rb + 8 * 128));
                const s16x4 b0 = __builtin_amdgcn_ds_read_tr16_b64_v4i16((LAS s16x4*)(rb + 64));
                const s16x4 b1 = __builtin_amdgcn_ds_read_tr16_b64_v4i16((LAS s16x4*)(rb + 8 * 128 + 64));
                bf16x8 vf0, vf1;
                vf0[0] = a0[0]; vf0[1] = a0[1]; vf0[2] = a0[2]; vf0[3] = a0[3]; vf0[4] = a1[0]; vf0[5] = a1[1]; vf0[6] = a1[2]; vf0[7] = a1[3];
                vf1[0] = b0[0]; vf1[1] = b0[1]; vf1[2] = b0[2]; vf1[3] = b0[3]; vf1[4] = b1[0]; vf1[5] = b1[1]; vf1[6] = b1[2]; vf1[7] = b1[3];
                o0 = __builtin_amdgcn_mfma_f32_32x32x16_bf16(vf0, pb[s2], o0, 0, 0, 0);
                o1 = __builtin_amdgcn_mfma_f32_32x32x16_bf16(vf1, pb[s2], o1, 0, 0, 0);
            }
            cur = nxt;
        }
        l += __shfl_xor(l, 32);
        const int qloc = T.qloc;
        LAS float* orow = Ol + qloc * 64; const int sw = qloc & 15;
        if (br == 0) {
#pragma unroll
            for (int g4 = 0; g4 < 4; ++g4) { const int ch0 = 2 * g4 + h, ch1 = 8 + 2 * g4 + h;
                *(LAS f32x4*)(orow + ((ch0 ^ sw) * 4)) = (f32x4){o0[4 * g4], o0[4 * g4 + 1], o0[4 * g4 + 2], o0[4 * g4 + 3]};
                *(LAS f32x4*)(orow + ((ch1 ^ sw) * 4)) = (f32x4){o1[4 * g4], o1[4 * g4 + 1], o1[4 * g4 + 2], o1[4 * g4 + 3]}; }
            if (h == 0) { Ml[qloc] = m; Ll[qloc] = l; }
        } else {
            const float m0 = Ml[qloc], l0 = Ll[qloc];
            const float mn = fmaxf(m0, m), a0 = fast_exp2(m0 - mn), a1 = fast_exp2(m - mn);
#pragma unroll
            for (int g4 = 0; g4 < 4; ++g4) { const int ch0 = 2 * g4 + h, ch1 = 8 + 2 * g4 + h;
                LAS f32x4* q0 = (LAS f32x4*)(orow + ((ch0 ^ sw) * 4)); LAS f32x4* q1 = (LAS f32x4*)(orow + ((ch1 ^ sw) * 4));
                const f32x4 x0 = *q0, x1 = *q1;
                *q0 = x0 * a0 + (f32x4){o0[4 * g4], o0[4 * g4 + 1], o0[4 * g4 + 2], o0[4 * g4 + 3]} * a1;
                *q1 = x1 * a0 + (f32x4){o1[4 * g4], o1[4 * g4 + 1], o1[4 * g4 + 2], o1[4 * g4 + 3]} * a1; }
            if (h == 0) { Ml[qloc] = mn; Ll[qloc] = l0 * a0 + l * a1; }
        }
        if (n & 1) __syncthreads();
        T = Tn;
#pragma unroll
        for (int s = 0; s < 4; ++s) qf[s] = qn[s];
    }
#pragma unroll 2
    for (int it = 0; it < 8; ++it) { const int idx = it * 512 + tid, qi = idx >> 3, oc = idx & 7;
        const float inv = 1.0f / Ll[qi]; const int sw = qi & 15;
        const f32x4 a = *(LAS f32x4*)(Ol + qi * 64 + (((2 * oc) ^ sw) * 4)), bq = *(LAS f32x4*)(Ol + qi * 64 + (((2 * oc + 1) ^ sw) * 4));
        u32x4 w; w.x = pk2(a[0] * inv, a[1] * inv); w.y = pk2(a[2] * inv, a[3] * inv); w.z = pk2(bq[0] * inv, bq[1] * inv); w.w = pk2(bq[2] * inv, bq[3] * inv);
        *(u32x4*)(MIX + (tok0 + p0 + qi) * 1024 + 64 * hh + 8 * oc) = w; }
    __syncthreads();
}
__device__ __forceinline__ void pool_wave(const Params& p, int task, int lane) {
    const bf16_t* U = (const bf16_t*)(p.ws + WS_QKVU) + 1536 + 8 * lane;
    bf16_t* MIX = (bf16_t*)(p.ws + WS_H) + 512 + 8 * lane;
    const int t0 = task * 8, pos0 = t0 & 8191;
    const int g = lane >> 4, w = 2 << g;
    u32x4 rw[23];
#pragma unroll
    for (int j = 0; j < 23; ++j) { rw[j] = (u32x4){0u, 0u, 0u, 0u}; if (pos0 - 15 + j >= 0) rw[j] = *(const u32x4*)(U + (size_t)(t0 - 15 + j) * 2048); }
    float sum[8];
#pragma unroll
    for (int ch = 0; ch < 8; ++ch) sum[ch] = 0.f;
#pragma unroll
    for (int j = 0; j < 15; ++j) { const bool in = (j >= 16 - w);
#pragma unroll
        for (int q = 0; q < 4; ++q) { const unsigned v = in ? rw[j][q] : 0u; sum[2 * q] += __uint_as_float(v << 16); sum[2 * q + 1] += __uint_as_float(v & 0xffff0000u); } }
#pragma unroll
    for (int k = 0; k < 8; ++k) {
        float cur[8], o[8];
#pragma unroll
        for (int q = 0; q < 4; ++q) { const unsigned v = rw[15 + k][q]; cur[2 * q] = __uint_as_float(v << 16); cur[2 * q + 1] = __uint_as_float(v & 0xffff0000u); }
        const int posk = pos0 + k; const float inv = 1.0f / (float)((posk + 1 < w) ? (posk + 1) : w);
#pragma unroll
        for (int ch = 0; ch < 8; ++ch) { sum[ch] += cur[ch]; o[ch] = sum[ch] * inv - cur[ch]; }
        u32x4 w4; w4.x = pk2(o[0], o[1]); w4.y = pk2(o[2], o[3]); w4.z = pk2(o[4], o[5]); w4.w = pk2(o[6], o[7]);
        *(u32x4*)(MIX + (size_t)(t0 + k) * 1024) = w4;
#pragma unroll
        for (int q = 0; q < 4; ++q) { const unsigned v = g == 0 ? rw[14 + k][q] : g == 1 ? rw[12 + k][q] : g == 2 ? rw[8 + k][q] : rw[k][q];
            sum[2 * q] -= __uint_as_float(v << 16); sum[2 * q + 1] -= __uint_as_float(v & 0xffff0000u); } }
}
__device__ __forceinline__ void phase_attn(const Params& p, LAS unsigned char* lds, int tid, int wave, int lane, int rep) {
    const bool probe = PROBE_ATT && REPS(3) == 2 && rep == 0;
    const bool swz = gridDim.x == 256;
#pragma unroll 1
    for (int k = blockIdx.x; k < 1024; k += gridDim.x) { const int xcd = k & 7, local = (k >> 3) & 31, round = k >> 8;
        attn_item(p, lds, swz ? (local & 15) + 16 * ((2 * round + (local >> 4)) + 8 * xcd) : k, tid, wave, lane, probe); }
    if (probe) return;
    if (gridDim.x == 256) {
        const int x = blockIdx.x & 7, wl = (blockIdx.x >> 3) * 8 + wave;
#pragma unroll 1
        for (int k = 0; k < 4; ++k) pool_wave(p, x * 1024 + k * 256 + wl, lane);
    } else
    for (int task = blockIdx.x * 8 + wave; task < T_ / 8; task += gridDim.x * 8) pool_wave(p, task, lane);
}

typedef unsigned u32x2s __attribute__((ext_vector_type(2)));
#define CE_DESC(a, b) do { const float _x = (a), _y = (b); (a) = fmaxf(_x, _y); (b) = fminf(_x, _y); } while (0)
template <int N, int K, int J, int I> __device__ __forceinline__ void bs_i(float (&v)[N]) {
    if constexpr (I < N) {
        constexpr int L = I ^ J;
        if constexpr (L > I) { const float x = v[I], y = v[L]; const float mx = fmaxf(x, y), mn = fminf(x, y);
            if constexpr ((I & K) == 0) { v[I] = mx; v[L] = mn; } else { v[I] = mn; v[L] = mx; } }
        bs_i<N, K, J, I + 1>(v);
    }
}
template <int N, int K, int J> __device__ __forceinline__ void bs_j(float (&v)[N]) { if constexpr (J > 0) { bs_i<N, K, J, 0>(v); bs_j<N, K, J / 2>(v); } }
template <int N, int K> __device__ __forceinline__ void bs_k(float (&v)[N]) { if constexpr (K <= N) { bs_j<N, K, K / 2>(v); bs_k<N, K * 2>(v); } }
template <int N> __device__ __forceinline__ void bitonic_sort_desc(float (&v)[N]) { bs_k<N, 2>(v); }
__device__ __forceinline__ void bitonic_merge_desc16(float (&v)[16]) { bs_j<16, 16, 8>(v); }
__device__ __forceinline__ void sort16_desc(float (&v)[16]) {
    CE_DESC(v[0], v[13]); CE_DESC(v[1], v[12]); CE_DESC(v[2], v[15]); CE_DESC(v[3], v[14]); CE_DESC(v[4], v[8]); CE_DESC(v[5], v[6]); CE_DESC(v[7], v[11]); CE_DESC(v[9], v[10]);
    CE_DESC(v[0], v[5]); CE_DESC(v[1], v[7]); CE_DESC(v[2], v[9]); CE_DESC(v[3], v[4]); CE_DESC(v[6], v[13]); CE_DESC(v[8], v[14]); CE_DESC(v[10], v[15]); CE_DESC(v[11], v[12]);
    CE_DESC(v[0], v[1]); CE_DESC(v[2], v[3]); CE_DESC(v[4], v[5]); CE_DESC(v[6], v[8]); CE_DESC(v[7], v[9]); CE_DESC(v[10], v[11]); CE_DESC(v[12], v[13]); CE_DESC(v[14], v[15]);
    CE_DESC(v[0], v[2]); CE_DESC(v[1], v[3]); CE_DESC(v[4], v[10]); CE_DESC(v[5], v[11]); CE_DESC(v[6], v[7]); CE_DESC(v[8], v[9]); CE_DESC(v[12], v[14]); CE_DESC(v[13], v[15]);
    CE_DESC(v[1], v[2]); CE_DESC(v[3], v[12]); CE_DESC(v[4], v[6]); CE_DESC(v[5], v[7]); CE_DESC(v[8], v[10]); CE_DESC(v[9], v[11]); CE_DESC(v[13], v[14]);
    CE_DESC(v[1], v[4]); CE_DESC(v[2], v[6]); CE_DESC(v[5], v[8]); CE_DESC(v[7], v[10]); CE_DESC(v[9], v[13]); CE_DESC(v[11], v[14]);
    CE_DESC(v[2], v[4]); CE_DESC(v[3], v[6]); CE_DESC(v[9], v[12]); CE_DESC(v[11], v[13]);
    CE_DESC(v[3], v[5]); CE_DESC(v[6], v[8]); CE_DESC(v[7], v[9]); CE_DESC(v[10], v[12]);
    CE_DESC(v[3], v[4]); CE_DESC(v[5], v[6]); CE_DESC(v[7], v[8]); CE_DESC(v[9], v[10]); CE_DESC(v[11], v[12]);
    CE_DESC(v[6], v[7]); CE_DESC(v[8], v[9]);
}
__device__ __forceinline__ void merge_top16(float (&a)[16], const float (&b)[16]) {
#pragma unroll
    for (int i = 0; i < 16; ++i) a[i] = fmaxf(a[i], b[15 - i]);
    bitonic_merge_desc16(a);
}
__device__ __forceinline__ void cross_half_merge(float (&a)[16]) {
    float o[16];
#pragma unroll
    for (int i = 0; i < 16; ++i) { const u32x2s r = __builtin_amdgcn_permlane32_swap(__float_as_uint(a[i]), __float_as_uint(a[i]), false, false); a[i] = __uint_as_float(r.x); o[i] = __uint_as_float(r.y); }
    merge_top16(a, o);
}
__device__ constexpr int cand_i(int n) { return n < 15 ? 0 : n < 21 ? 1 : n < 23 ? 2 : n < 27 ? (n - 23) : -1; }
__device__ constexpr int cand_j(int n) { return n < 15 ? (n + 1) : n < 21 ? (n - 15 + 2) : n < 23 ? (n - 21 + 3) : n < 27 ? (n - 23) : -1; }

struct RouteQ { bf16x8 a[8], b[8]; };
__device__ __forceinline__ void route_load_q(RouteQ& q, const Params& p, int unit, int lane) {
    const int hd = unit & 7, t0 = (unit >> 3) * 32, i = lane & 31, h = lane >> 5;
    const bf16_t* qp = (const bf16_t*)(p.ws + WS_QKVU) + (size_t)(t0 + i) * 2048 + hd * 256 + 8 * h;
#pragma unroll
    for (int s = 0; s < 8; ++s) { q.a[s] = *(const bf16x8*)(qp + 16 * s); q.b[s] = *(const bf16x8*)(qp + 128 + 16 * s); }
}
__device__ __forceinline__ void route_half(const bf16x8 (&qf)[8], const LAS unsigned char* skl, int i, int h, float (&g0)[16]) {
#pragma unroll
    for (int mt = 0; mt < 4; ++mt) {
        f32x16 acc;
#pragma unroll
        for (int e = 0; e < 16; ++e) acc[e] = 0.f;
#pragma unroll
        for (int s = 0; s < 8; ++s) { const bf16x8 kf = *(const LAS bf16x8*)(skl + mt * 8192 + i * 256 + ((((2 * s + h) ^ (i & 15))) << 4)); acc = __builtin_amdgcn_mfma_f32_32x32x16_bf16(kf, qf[s], acc, 0, 0, 0); }
        float gt[16];
#pragma unroll
        for (int rho = 0; rho < 16; ++rho) { const unsigned key = 32 * mt + (rho & 3) + 8 * (rho >> 2) + 4 * h;
            gt[rho] = __uint_as_float((__float_as_uint(acc[rho]) & ~127u) | key); }
        sort16_desc(gt);
        if (mt == 0) {
#pragma unroll
            for (int e = 0; e < 16; ++e) g0[e] = gt[e];
        } else merge_top16(g0, gt);
    }
    cross_half_merge(g0);
}
__device__ __forceinline__ void route_unit(const Params& p, const LAS unsigned char* skl, LAS unsigned char* scr, int unit, int next_unit, RouteQ& q, int lane) {
    const int hd = unit & 7, t0 = (unit >> 3) * 32;
    const int i = lane & 31, h = lane >> 5;
    float topA[16], topB[16];
    route_half(q.a, skl, i, h, topA);
    route_half(q.b, skl + 32768, i, h, topB);
    if (next_unit >= 0) route_load_q(q, p, next_unit, lane);
    LAS unsigned* sw32 = (LAS unsigned*)(scr + i * 32);
    if (h == 0) {
#pragma unroll
        for (int q = 0; q < 4; ++q) {
            sw32[q] = (__float_as_uint(topA[4 * q]) & 127u) | ((__float_as_uint(topA[4 * q + 1]) & 127u) << 8) | ((__float_as_uint(topA[4 * q + 2]) & 127u) << 16) | ((__float_as_uint(topA[4 * q + 3]) & 127u) << 24);
            sw32[4 + q] = (__float_as_uint(topB[4 * q]) & 127u) | ((__float_as_uint(topB[4 * q + 1]) & 127u) << 8) | ((__float_as_uint(topB[4 * q + 2]) & 127u) << 16) | ((__float_as_uint(topB[4 * q + 3]) & 127u) << 24);
        }
    }
    float X[16], Y[16];
#pragma unroll
    for (int e = 0; e < 16; ++e) { X[e] = h ? topB[e] : topA[e]; Y[e] = h ? topA[e] : topB[e]; }
    float c0[16], c1[16];
#pragma unroll
    for (int n = 0; n < 32; ++n) {
        float v;
        if (n < 27) { const int ci = cand_i(n), cj = cand_j(n);
            const float sum = X[ci] + Y[cj];
            const unsigned code = h ? (unsigned)((cj << 4) | ci) : (unsigned)((ci << 4) | cj);
            v = __uint_as_float((__float_as_uint(sum) & ~255u) | code);
            if (n >= 23) v = h ? -INFINITY : v; }
        else v = -INFINITY;
        if (n < 16) c0[n] = v; else c1[n - 16] = v;
    }
    sort16_desc(c0); sort16_desc(c1);
    merge_top16(c0, c1);
    cross_half_merge(c0);
    const float LOG2E = 1.4426950408889634f;
    float ge[16]; float Z = 0.f;
#pragma unroll
    for (int k = 0; k < 16; ++k) { ge[k] = fast_exp2((c0[k] - c0[0]) * LOG2E); Z += ge[k]; }
    const float invZ = 1.0f / Z;
    const LAS unsigned char* sb = (const LAS unsigned char*)(scr + i * 32);
    unsigned eid[16];
#pragma unroll
    for (int k = 0; k < 16; ++k) { const unsigned code = __float_as_uint(c0[k]) & 255u; const unsigned ai = sb[code >> 4], bi = sb[16 + (code & 15)]; eid[k] = ai * 128u + bi; }
    const size_t slot = (size_t)(t0 + i) * 128 + hd * 16;
    if (h == 0) {
        unsigned short* E = (unsigned short*)(p.ws + WS_EID) + slot;
        u32x4 w0, w1;
        w0.x = eid[0] | (eid[1] << 16); w0.y = eid[2] | (eid[3] << 16); w0.z = eid[4] | (eid[5] << 16); w0.w = eid[6] | (eid[7] << 16);
        w1.x = eid[8] | (eid[9] << 16); w1.y = eid[10] | (eid[11] << 16); w1.z = eid[12] | (eid[13] << 16); w1.w = eid[14] | (eid[15] << 16);
        *(u32x4*)E = w0; *(u32x4*)(E + 8) = w1;
    } else {
        float* G = (float*)(p.ws + WS_GATE) + slot;
#pragma unroll
        for (int q = 0; q < 4; ++q) *(f32x4*)(G + 4 * q) = (f32x4){ge[4 * q] * invZ, ge[4 * q + 1] * invZ, ge[4 * q + 2] * invZ, ge[4 * q + 3] * invZ};
    }
}
__device__ __forceinline__ void phase_route(const Params& p, LAS unsigned char* lds, int tid, int gw, int nw, int wave, int lane) {
    { const u32x4* src = (const u32x4*)(p.ws + WS_SK);
#pragma unroll
      for (int it = 0; it < 8; ++it) { const int idx = it * 512 + tid, n = (idx >> 4) & 127, c = idx & 15, pp = idx >> 11;
          *(LAS u32x4*)(lds + pp * 32768 + n * 256 + ((c ^ (n & 15)) << 4)) = src[idx]; } }
    __syncthreads();
    LAS unsigned char* scr = lds + 65536 + wave * 1024;
    if (gridDim.x == 256) {
        const int x = blockIdx.x & 7, wl = (blockIdx.x >> 3) * 8 + wave;
        RouteQ q; route_load_q(q, p, ((x * 256 + 255 - (wl >> 3)) << 3) | (wl & 7), lane);
#pragma unroll 1
        for (int k = 0; k < 8; ++k) route_unit(p, lds, scr, ((x * 256 + 255 - (32 * k + (wl >> 3))) << 3) | (wl & 7), k < 7 ? (((x * 256 + 255 - (32 * (k + 1) + (wl >> 3))) << 3) | (wl & 7)) : -1, q, lane);
    } else {
        RouteQ q; if (gw < (T_ / 32) * 8) route_load_q(q, p, gw, lane);
        for (int u = gw; u < (T_ / 32) * 8; u += nw) route_unit(p, lds, scr, u, u + nw < (T_ / 32) * 8 ? u + nw : -1, q, lane); }
}

#define XB_TMO      128
#define XB_XCNT(j)  (256  + 64 * (j))
#define XB_XSUB(j)  (1280 + 64 * (j))
#define XB_XGEN(j)  (2304 + 64 * (j))
#define XB_TOP      3328
#define XB_GMASK(j) (7168 + 64 * (j))
#define XB_TOPGEN   3392
#define XCD_BAR_WORDS 3456
#define XB_SPIN_CAP (1u << 20)
__device__ __forceinline__ unsigned xb_ld(unsigned* p)              { return __hip_atomic_load(p, __ATOMIC_RELAXED, __HIP_MEMORY_SCOPE_AGENT); }
__device__ __forceinline__ unsigned xb_add(unsigned* p, unsigned v) { return __hip_atomic_fetch_add(p, v, __ATOMIC_RELAXED, __HIP_MEMORY_SCOPE_AGENT); }
__device__ __forceinline__ unsigned xb_xcc_id() { return (unsigned)__builtin_amdgcn_s_getreg((3 << 11) | 20) & 0xFu; }
#define XB_SPIN(cond, bar) do { unsigned _sp = 0; while (cond) { __builtin_amdgcn_s_sleep(1); \
    if ((++_sp & 255u) == 0u) { if (xb_ld(&(bar)[XB_TMO])) break; if (_sp > XB_SPIN_CAP) { atomicAdd(&(bar)[XB_TMO], 1u); break; } } } } while (0)
struct XcdBarrier { unsigned* bar; unsigned x; volatile LAS unsigned* st; int w0; };
__device__ __forceinline__ XcdBarrier xcd_barrier_post(unsigned* bar, volatile LAS unsigned* st, int w0) {
    XcdBarrier b; b.bar = bar; b.x = xb_xcc_id(); b.st = st; b.w0 = w0;
    if (w0 == 0 && lane_id_() == 0) { (void)xb_add(&bar[XB_XCNT(b.x)], 1u); (void)__hip_atomic_fetch_or(&bar[XB_GMASK(blockIdx.x & 7)], 1u << b.x, __ATOMIC_RELAXED, __HIP_MEMORY_SCOPE_AGENT); }
    return b;
}
__device__ __forceinline__ void xcd_barrier_complete(unsigned* bar, unsigned x, unsigned& nloc, unsigned& nx) {
    const unsigned G = gridDim.x * gridDim.y * gridDim.z;
    unsigned sum, cnt, mine, sp = 0u;
    for (;;) {
        sum = 0u; cnt = 0u; mine = 0u;
#pragma unroll
        for (unsigned j = 0; j < 16; ++j) { const unsigned c = xb_ld(&bar[XB_XCNT(j)]); sum += c; cnt += (c > 0u) ? 1u : 0u; mine = (j == x) ? c : mine; }
        if (sum == G) break;
        __builtin_amdgcn_s_sleep(1);
        if ((++sp & 255u) == 0u) { if (xb_ld(&bar[XB_TMO])) break; if (sp > XB_SPIN_CAP) { atomicAdd(&bar[XB_TMO], 1u); break; } }
    }
    nloc = mine > 0u ? mine : 1u; nx = cnt > 0u ? cnt : 1u;
}
__device__ __forceinline__ void xcd_barrier(const XcdBarrier& b, bool local_phase = false) {
    asm volatile("s_waitcnt vmcnt(0)" ::: "memory");
    __syncthreads();
    if (b.w0 == 0 && lane_id_() == 0) {
        unsigned* bar = b.bar;
        __builtin_amdgcn_s_waitcnt(0);
        unsigned nloc = b.st[0], nx = b.st[1];
        if (nloc == 0u) { xcd_barrier_complete(bar, b.x, nloc, nx); b.st[0] = nloc; b.st[1] = nx;
            unsigned ok = (gridDim.x == 256u && nloc == 32u && nx == 8u) ? 1u : 0u;
#pragma unroll
            for (unsigned g = 0; g < 8; ++g) { const unsigned m = xb_ld(&bar[XB_GMASK(g)]); ok &= (m != 0u && (m & (m - 1u)) == 0u) ? 1u : 0u; }
            b.st[2] = ok; }
        const bool skip_top = local_phase && b.st[2] != 0u;
        const unsigned old = xb_add(&bar[XB_XSUB(b.x)], 1u);
        const unsigned gen = old / nloc;
        if (old + 1u == (gen + 1u) * nloc) {
            if (!skip_top) {
                __builtin_amdgcn_fence(__ATOMIC_RELEASE, "agent");
                asm volatile("s_waitcnt vmcnt(0)" ::: "memory");
                const unsigned og = xb_add(&bar[XB_TOP], 1u);
                const unsigned tg = og / nx;
                if (og + 1u != (tg + 1u) * nx) XB_SPIN(xb_ld(&bar[XB_TOP]) < (tg + 1u) * nx, bar);
            }
            __builtin_amdgcn_fence(__ATOMIC_ACQUIRE, "agent");
            xb_add(&bar[XB_XGEN(b.x)], 1u);
            asm volatile("s_waitcnt vmcnt(0)" ::: "memory");
        } else {
            XB_SPIN(xb_ld(&bar[XB_XGEN(b.x)]) == gen, bar);
            __builtin_amdgcn_fence(__ATOMIC_ACQUIRE, "agent");
            asm volatile("s_waitcnt vmcnt(0)" ::: "memory");
        }
    }
    __syncthreads();
}
#define XB_HALF(j)  (7680 + 64 * (j))
__device__ __forceinline__ void half_barrier(unsigned* bar, int parity, int w0) {
    asm volatile("s_waitcnt vmcnt(0)" ::: "memory");
    __syncthreads();
    if (w0 == 0 && lane_id_() == 0) {
        __builtin_amdgcn_fence(__ATOMIC_RELEASE, "agent");
        (void)xb_add(&bar[XB_HALF(parity)], 1u);
        XB_SPIN(xb_ld(&bar[XB_HALF(parity)]) < 128u, bar);
        __builtin_amdgcn_fence(__ATOMIC_ACQUIRE, "agent");
        asm volatile("s_waitcnt vmcnt(0)" ::: "memory");
    }
    __syncthreads();
}
__device__ __forceinline__ void table_ballast(const Params& p, LAS unsigned char* lds, int tid, int w0, unsigned* bar, int tb) {
    const int bi = blockIdx.x >> 1;
#pragma unroll 1
    for (int k = 0; k < 4; ++k) p0_max_item(tb ? p.peer_v : p.peer_u, (float*)(p.ws + WS_PMAX), tb * 512 + k * 128 + bi, lds, tid);
    half_barrier(bar, tb, w0);
    phase_tables_fp8(p, lds, tid, bi, 128, tb, tb + 1);
}

__device__ __forceinline__ float gelu_exact(float v) { return 0.5f * v * (1.0f + erff(v * 0.70710678118654752f)); }
constexpr int PEER_TPW = 32, PEER_NCH = T_ / PEER_TPW;
__device__ __forceinline__ int grab_item(unsigned* head, int lane) {
    unsigned v = 0u;
    if (lane == 0) v = __hip_atomic_fetch_add(head, 1u, __ATOMIC_RELAXED, __HIP_MEMORY_SCOPE_AGENT);
    return __builtin_amdgcn_readfirstlane((int)v);
}
typedef float f32x2v __attribute__((ext_vector_type(2)));
typedef int i32x8 __attribute__((ext_vector_type(8)));
struct USmall { unsigned ew, hw0, hw1; float hs; u32x4 ea, eb; };
__device__ __forceinline__ void u_load_small(USmall& s, const unsigned short* eidrow, const bf16_t* hrow, const float* hscp, int lane) {
    s.ew = ((const unsigned*)eidrow)[(unsigned)lane];
    const u32x2 hh = ((const u32x2*)hrow)[(unsigned)lane]; s.hw0 = hh.x; s.hw1 = hh.y;
    unsigned z = 0; asm volatile("" : "+v"(z)); s.hs = hscp[z];
}
__device__ __forceinline__ void u_spread_small(USmall& s, int r) {
#pragma unroll
    for (int q = 0; q < 4; ++q) { s.ea[q] = __shfl(s.ew, 8 * r + q); s.eb[q] = __shfl(s.ew, 8 * r + 4 + q); }
}
__device__ __forceinline__ void u_compute(const USmall& s, const u32x4 (&ur)[16], LAS float* partrow, LAS unsigned char* scr, int lane, int i, int g) {
    const float sc8 = __uint_as_float(0x7f000000u - __float_as_uint(s.hs));
    int hw8 = __builtin_amdgcn_cvt_pk_fp8_f32(__uint_as_float(s.hw0 << 16) * sc8, __uint_as_float(s.hw0 & 0xffff0000u) * sc8, 0, false);
    hw8 = __builtin_amdgcn_cvt_pk_fp8_f32(__uint_as_float(s.hw1 << 16) * sc8, __uint_as_float(s.hw1 & 0xffff0000u) * sc8, hw8, true);
    i32x8 b0, b1;
#pragma unroll
    for (int q = 0; q < 8; ++q) { const int d = 4 * g + (q & 3) + 16 * (q >> 2); b0[q] = __shfl(hw8, d); b1[q] = __shfl(hw8, 32 + d); }
    const int r = lane >> 3, c = lane & 7;
    const unsigned wx = 16u * (unsigned)(r * 8 + (c ^ (r >> 1))), wy = 16u * (unsigned)(64 + r * 8 + (c ^ (4 + (r >> 1))));
    const unsigned ra = 16u * (unsigned)(i * 8 + (g ^ (i >> 1))), rb = 16u * (unsigned)(i * 8 + ((4 + g) ^ (i >> 1)));
    f32x4 acc[8];
#pragma unroll
    for (int half = 0; half < 2; ++half) {
        u32x4 a0[4], a1[4];
#pragma unroll
        for (int t4 = 0; t4 < 4; ++t4) { *(LAS u32x4*)(scr + t4 * 2048 + wx) = ur[4 * half + t4]; *(LAS u32x4*)(scr + t4 * 2048 + wy) = ur[8 + 4 * half + t4]; }
#pragma unroll
        for (int t4 = 0; t4 < 4; ++t4) { a0[t4] = *(const LAS u32x4*)(scr + t4 * 2048 + ra); a1[t4] = *(const LAS u32x4*)(scr + t4 * 2048 + rb); }
#pragma unroll
        for (int t4 = 0; t4 < 4; ++t4) { f32x4 a = {0.f, 0.f, 0.f, 0.f};
            i32x8 p0, p1;
            p0[0] = (int)a0[t4][0]; p0[1] = (int)a0[t4][1]; p0[2] = (int)a0[t4][2]; p0[3] = (int)a0[t4][3]; p0[4] = 0; p0[5] = 0; p0[6] = 0; p0[7] = 0;
            p1[0] = (int)a1[t4][0]; p1[1] = (int)a1[t4][1]; p1[2] = (int)a1[t4][2]; p1[3] = (int)a1[t4][3]; p1[4] = 0; p1[5] = 0; p1[6] = 0; p1[7] = 0;
            a = __builtin_amdgcn_mfma_scale_f32_16x16x128_f8f6f4(p0, b0, a, 4, 0, 0, 0x7f7f7f7f, 0, 0x7f7f7f7f);
            a = __builtin_amdgcn_mfma_scale_f32_16x16x128_f8f6f4(p1, b1, a, 4, 0, 0, 0x7f7f7f7f, 0, 0x7f7f7f7f);
            acc[4 * half + t4] = a; }
    }
#pragma unroll
    for (int tau = 0; tau < 8; ++tau) asm volatile("" : "+v"(acc[tau]));
    const int rho = i & 3, m = i >> 2;
    float sel[8];
#pragma unroll
    for (int tau = 0; tau < 8; ++tau) { const float lo = (rho & 1) ? acc[tau][1] : acc[tau][0], hi2 = (rho & 1) ? acc[tau][3] : acc[tau][2]; sel[tau] = (rho & 2) ? hi2 : lo; }
    float v0 = sel[0], v1 = sel[1];
#pragma unroll
    for (int mm = 1; mm < 4; ++mm) { v0 = (m == mm) ? sel[2 * mm] : v0; v1 = (m == mm) ? sel[2 * mm + 1] : v1; }
    const int R = 4 * g + rho;
    half2_t o; o.x = (_Float16)v0; o.y = (_Float16)v1;
    *(LAS half2_t*)((LAS _Float16*)partrow + (unsigned)(16 * (R & 7) + 8 * (R >> 3) + 2 * m)) = o;
}
__device__ __forceinline__ unsigned eid_of(const u32x4& ea, const u32x4& eb, int it) { const unsigned w = (it < 8) ? ea[(it >> 1) & 3] : eb[(it >> 1) & 3]; return (it & 1) ? (w >> 16) : (w & 0xffffu); }
#ifndef PROBE_SKIP
#define PROBE_SKIP 0
#endif
struct VIds { unsigned ew; u32x4 ea, eb; };
struct VCf { unsigned cw; float csc; };
struct VXm { u32x2 mw; f32x4 xv; };
__device__ __forceinline__ void v_load_ids(VIds& s, const unsigned short* eidrow, int lane) { s.ew = __builtin_nontemporal_load((const unsigned*)eidrow + (unsigned)lane); }
__device__ __forceinline__ void v_spread_ids(VIds& s, int r) {
#pragma unroll
    for (int q = 0; q < 4; ++q) { s.ea[q] = __shfl(s.ew, 8 * r + q); s.eb[q] = __shfl(s.ew, 8 * r + 4 + q); }
}
__device__ __forceinline__ void v_load_cf(VCf& s, const unsigned char* coefrow, const float* cscp, int lane) {
    s.cw = __builtin_nontemporal_load((const unsigned*)coefrow + (unsigned)(lane & 31));
    unsigned z = 0; asm volatile("" : "+v"(z)); s.csc = cscp[z];
}
__device__ __forceinline__ void v_load_xm(VXm& s, const float* xrow, const bf16_t* mrow, unsigned colb) {
    s.xv = __builtin_nontemporal_load((const f32x4*)(xrow + colb)); s.mw = __builtin_nontemporal_load((const u32x2*)(mrow + colb));
}
typedef int i32x2v __attribute__((ext_vector_type(2)));
__device__ __forceinline__ void v_compute(const VCf& s, const VXm& xm, const u32x4 (&vr)[16], const LAS float* gc, LAS float* outrow, LAS unsigned char* gb, int lane, unsigned colb, bool abl = false) {
    const int r = lane >> 3, c = lane & 7, i = lane & 15, g = lane >> 4;
    i32x8 b;
#pragma unroll
    for (int q = 0; q < 8; ++q) b[q] = (int)__shfl(s.cw, 16 * (q >> 2) + 8 * (g >> 1) + 4 * ((q >> 1) & 1) + 2 * (g & 1) + (q & 1));
    const unsigned wb = 144u * (unsigned)(8 * r) + 16u * (unsigned)c, rb = 144u * (unsigned)(16 * g + i);
    f32x4 val0 = {0.f, 0.f, 0.f, 0.f}, val1 = {0.f, 0.f, 0.f, 0.f};
    int iv = i; asm volatile("" : "+v"(iv));
    i32x2v R0[16];
    if (!((PROBE_SKIP & 2) && abl)) {
#pragma unroll
        for (int it = 0; it < 8; ++it) *(LAS u32x4*)(gb + wb + 144 * it) = vr[it]; }
#pragma unroll
    for (int ct = 0; ct < 16; ++ct) R0[ct] = __builtin_amdgcn_ds_read_tr4_b64_v2i32((LAS i32x2v*)(gb + rb + 8 * ct));
    __builtin_amdgcn_sched_barrier(0);
    if (!((PROBE_SKIP & 2) && abl)) {
#pragma unroll
        for (int it = 0; it < 8; ++it) *(LAS u32x4*)(gb + wb + 144 * it) = vr[8 + it]; }
#pragma unroll
    for (int bt = 0; bt < 4; ++bt) {
        i32x2v R1[4];
#pragma unroll
        for (int q = 0; q < 4; ++q) R1[q] = __builtin_amdgcn_ds_read_tr4_b64_v2i32((LAS i32x2v*)(gb + rb + 8 * (4 * bt + q)));
#pragma unroll
        for (int q = 0; q < 4; ++q) { const int ct = 4 * bt + q;
            i32x8 a; a[0] = R0[ct].x; a[1] = R0[ct].y; a[2] = R1[q].x; a[3] = R1[q].y; a[4] = 0; a[5] = 0; a[6] = 0; a[7] = 0;
            const int sb = (iv == ct) ? 0x7f7f7f7f : 0;
            if (q & 1) val1 = __builtin_amdgcn_mfma_scale_f32_16x16x128_f8f6f4(a, b, val1, 4, 0, 0, 0x7f7f7f7f, 0, sb);
            else       val0 = __builtin_amdgcn_mfma_scale_f32_16x16x128_f8f6f4(a, b, val0, 4, 0, 0, 0x7f7f7f7f, 0, sb); }
        __builtin_amdgcn_sched_barrier(0); }
    asm volatile("" : "+v"(val0), "+v"(val1));
    const f32x4 val = val0 + val1;
    const float cs = s.csc;
    const f32x4 gv = *(const LAS f32x4*)(gc + lane * 4), g1v = *(const LAS f32x4*)(gc + 256 + lane * 4);
    f32x4 x2;
    x2[0] = (xm.xv[0] + g1v[0] * __uint_as_float(xm.mw.x << 16)) + gv[0] * (cs * val[0]); x2[1] = (xm.xv[1] + g1v[1] * __uint_as_float(xm.mw.x & 0xffff0000u)) + gv[1] * (cs * val[1]);
    x2[2] = (xm.xv[2] + g1v[2] * __uint_as_float(xm.mw.y << 16)) + gv[2] * (cs * val[2]); x2[3] = (xm.xv[3] + g1v[3] * __uint_as_float(xm.mw.y & 0xffff0000u)) + gv[3] * (cs * val[3]);
    u32x2 w2; w2.x = pk2(x2[0], x2[1]); w2.y = pk2(x2[2], x2[3]);
    *(LAS u32x2*)((LAS bf16_t*)outrow + colb) = w2;
}
__device__ __forceinline__ void gather16(u32x4 (&dst)[16], const unsigned char* tab, const u32x4& ea, const u32x4& eb, int c, bool dead) {
#pragma unroll
    for (int it = 0; it < 16; ++it) { const unsigned e = dead ? 0u : eid_of(ea, eb, it); dst[it] = *(const u32x4*)(tab + (e * 128u + 16u * c)); }
}
#ifndef PROBE_DEAD
#define PROBE_DEAD 0
#endif
struct PeerItem { int P, t0; bool ok; };
__device__ __forceinline__ PeerItem peer_draw(unsigned* heads, int x, int& k, int lane, int nparts, int nch, int tpw) {
    PeerItem it; it.P = 0; it.t0 = 0; it.ok = false;
    while (k < nparts) { const int P = (x + k) & (nparts - 1); const int ch = grab_item(heads + 64 * P, lane);
        if (ch < nch) { it.P = P; it.t0 = ch * tpw; it.ok = true; break; }
        ++k; }
    return it;
}
template <bool VPASS> __device__ __forceinline__ void phase_peer_part(const Params& p, LAS unsigned char* lds, int tid, int wave, int lane, int rep) {
    const bool pdead = PROBE_DEAD && rep > 0;
    unsigned* heads = (unsigned*)(p.ws + WS_BAR) + 4096 + (VPASS ? 512 : 0) + rep * 1024;
    const int x = (int)(xb_xcc_id() & 7u);
    const unsigned short* EID = (const unsigned short*)(p.ws + WS_EID);
    const int r = lane >> 3, c = lane & 7;
    const unsigned colb = 16 * c + 2 * ((lane >> 3) & 1) + 4 * ((lane >> 4) & 1) + 8 * ((lane >> 5) & 1);
    constexpr int TPW = PEER_TPW, NJ = TPW / 2;
    LAS float* wbuf = (LAS float*)(lds + 4096 + wave * (TPW * 512));
    int k = 0;
    if (!VPASS) {
        PeerItem cur = peer_draw(heads, x, k, lane, 4, PEER_NCH, TPW);
        if (!cur.ok) return;
        const int li = lane & 15, lg = lane >> 4;
        const bf16_t* H8b = (const bf16_t*)(p.ws + WS_H); const float* HSCp = (const float*)(p.ws + WS_HSC);
        LAS unsigned char* scr = (LAS unsigned char*)(wbuf + 2048);
        USmall sA, sB, sN; u32x4 A[16], B[16];
        u_load_small(sA, EID + (size_t)cur.t0 * 128, H8b + 256 * cur.P + (size_t)cur.t0 * 1024, HSCp + cur.t0, lane);
        u_load_small(sB, EID + (size_t)(cur.t0 + 1) * 128, H8b + 256 * cur.P + (size_t)(cur.t0 + 1) * 1024, HSCp + cur.t0 + 1, lane);
        u_spread_small(sA, r);
        gather16(A, p.ws + WS_U8 + (size_t)cur.P * 2097152, sA.ea, sA.eb, c, pdead);
        for (;;) {
            const PeerItem nxt = peer_draw(heads, x, k, lane, 4, PEER_NCH, TPW);
            const int P = cur.P, t0 = cur.t0;
            const unsigned char* U8p = p.ws + WS_U8 + (size_t)P * 2097152; const bf16_t* H = H8b + 256 * P;
            _Float16* PART = (pdead ? (_Float16*)p.out : (_Float16*)(p.ws + WS_PART)) + (size_t)P * T_ * 128;
            const unsigned char* U8n = p.ws + WS_U8 + (size_t)(nxt.ok ? nxt.P : P) * 2097152; const bf16_t* Hn = H8b + 256 * (nxt.ok ? nxt.P : P); const int tn = nxt.ok ? nxt.t0 : t0;
#pragma unroll 1
            for (int j = 0; j < NJ; ++j) { const int ta = t0 + 2 * j; const bool last = (j + 1 == NJ);
                { const int t2 = last ? tn : ta + 2; u_load_small(sN, EID + (size_t)t2 * 128, (last ? Hn : H) + (size_t)t2 * 1024, HSCp + t2, lane); }
                __builtin_amdgcn_sched_barrier(0);
                u_spread_small(sB, r);
                gather16(B, U8p, sB.ea, sB.eb, c, pdead);
                __builtin_amdgcn_sched_barrier(0);
                u_compute(sA, A, wbuf + (2 * j) * 64, scr, lane, li, lg);
                { const int t3 = last ? tn + 1 : ta + 3; u_load_small(sA, EID + (size_t)t3 * 128, (last ? Hn : H) + (size_t)t3 * 1024, HSCp + t3, lane); }
                __builtin_amdgcn_sched_barrier(0);
                u_spread_small(sN, r);
                gather16(A, last ? U8n : U8p, sN.ea, sN.eb, c, (last && !nxt.ok) || pdead);
                __builtin_amdgcn_sched_barrier(0);
                u_compute(sB, B, wbuf + (2 * j + 1) * 64, scr, lane, li, lg);
                { const unsigned e2 = sA.ew, h20 = sA.hw0, h21 = sA.hw1; const float hs2 = sA.hs; sA = sN; sB.ew = e2; sB.hw0 = h20; sB.hw1 = h21; sB.hs = hs2; } }
#pragma unroll 4
            for (int q = 0; q < TPW / 4; ++q) { const int idx = q * 64 + lane; const f32x4 v = *(const LAS f32x4*)(wbuf + idx * 4);
                *(f32x4*)((float*)(PART + (size_t)t0 * 128) + (size_t)idx * 4) = v; }
            if (!nxt.ok) break;
            cur = nxt;
        }
    } else {
        constexpr int TV = 8, NJV = TV / 2, NCHV = T_ / TV;
        const unsigned colv = 16 * (lane & 15) + 4 * (lane >> 4);
        LAS float* gc = wbuf + 3584;
        LAS unsigned char* gb = (LAS unsigned char*)(wbuf + 1024);
        PeerItem cur = peer_draw(heads, x, k, lane, 4, NCHV, TV);
        if (!cur.ok) return;
        const unsigned char* COEF = p.ws + WS_COEF; const float* CSC = (const float*)(p.ws + WS_COEF + 16777216); const bf16_t* MXb = (const bf16_t*)(p.ws + WS_X1);
        const float* modb = (const float*)(p.ws + WS_MOD); const float inv_sv = ((const float*)(p.ws + WS_CTL))[65];
        VIds iB, iN; VCf cA, cB; VXm xA, xB; u32x4 A[16], B[16];
        v_load_ids(iN, EID + (size_t)cur.t0 * 128, lane); v_load_ids(iB, EID + (size_t)(cur.t0 + 1) * 128, lane);
        v_load_cf(cA, COEF + (size_t)cur.t0 * 128, CSC + cur.t0, lane);
        v_spread_ids(iN, r);
        gather16(A, p.ws + WS_V8 + (size_t)cur.P * 2097152, iN.ea, iN.eb, c, pdead);
        for (;;) {
            const PeerItem nxt = peer_draw(heads, x, k, lane, 4, NCHV, TV);
            const int P = cur.P, t0 = cur.t0;
            const unsigned char* V8q = p.ws + WS_V8 + (size_t)P * 2097152; const float* X1 = p.x + 256 * P; const bf16_t* MX = MXb + 256 * P;
            *(LAS f32x4*)(gc + 256 + lane * 4) = *(const f32x4*)(modb + (size_t)(t0 >> 13) * MODW + 2048 + 256 * P + colv);
            *(LAS f32x4*)(gc + lane * 4) = *(const f32x4*)(modb + (size_t)(t0 >> 13) * MODW + 5120 + 256 * P + colv) * inv_sv;
            bf16_t* X2 = (bf16_t*)(p.ws + (pdead ? WS_PART : WS_H)) + 256 * P;
            const int Pn = nxt.ok ? nxt.P : P, tn = nxt.ok ? nxt.t0 : t0;
            const unsigned char* V8n = p.ws + WS_V8 + (size_t)Pn * 2097152;
#pragma unroll 1
            for (int j = 0; j < NJV; ++j) { const int ta = t0 + 2 * j; const bool last = (j + 1 == NJV);
                { const int t2 = last ? tn : ta + 2; v_load_ids(iN, EID + (size_t)t2 * 128, lane); }
                v_load_cf(cB, COEF + (size_t)(ta + 1) * 128, CSC + (ta + 1), lane);
                v_load_xm(xA, X1 + (size_t)ta * 1024, MX + (size_t)ta * 1024, colv);
                __builtin_amdgcn_sched_barrier(0);
                v_spread_ids(iB, r);
                gather16(B, V8q, iB.ea, iB.eb, c, pdead);
                __builtin_amdgcn_sched_barrier(0);
                v_compute(cA, xA, A, gc, wbuf + (2 * j) * 128, gb, lane, colv, pdead);
                { const int t3 = last ? tn + 1 : ta + 3; v_load_ids(iB, EID + (size_t)t3 * 128, lane);
                  const int t2 = last ? tn : ta + 2;
                  v_load_cf(cA, COEF + (size_t)t2 * 128, CSC + t2, lane); }
                v_load_xm(xB, X1 + (size_t)(ta + 1) * 1024, MX + (size_t)(ta + 1) * 1024, colv);
                __builtin_amdgcn_sched_barrier(0);
                v_spread_ids(iN, r);
                gather16(A, last ? V8n : V8q, iN.ea, iN.eb, c, (last && !nxt.ok) || pdead);
                __builtin_amdgcn_sched_barrier(0);
                v_compute(cB, xB, B, gc, wbuf + (2 * j + 1) * 128, gb, lane, colv, pdead); }
#pragma unroll 4
            for (int q = 0; q < TV; ++q) { const u32x2 v = *(const LAS u32x2*)(wbuf + q * 128 + lane * 2);
                *(u32x2*)(X2 + (size_t)(t0 + q) * 1024 + lane * 4) = v; }
            if (!nxt.ok) break;
            cur = nxt;
        }
    }
}
__device__ __forceinline__ void phase_peer_coef(const Params& p, int gw, int nw, int lane) {
    const float inv_su = ((const float*)(p.ws + WS_CTL))[64];
    const u32x4* PART = (const u32x4*)(p.ws + WS_PART); const float* GATE = (const float*)(p.ws + WS_GATE); u32x2* COEF = (u32x2*)(p.ws + WS_COEF); float* CSC = (float*)(p.ws + WS_COEF + 16777216);
    for (int chunk = gw; chunk < T_ / 32; chunk += nw)
#pragma unroll 2
        for (int rr = 0; rr < 8; ++rr) { const size_t o = ((size_t)chunk * 32 + rr * 4) * 16 + lane;
            float s[8];
#pragma unroll
            for (int k = 0; k < 8; ++k) s[k] = 0.f;
#pragma unroll
            for (int P = 0; P < 4; ++P) { const u32x4 w = PART[(size_t)P * T_ * 16 + o];
#pragma unroll
                for (int q = 0; q < 4; ++q) { const unsigned wq = w[q]; const half2_t hh = __builtin_bit_cast(half2_t, wq); s[2 * q] += (float)hh.x; s[2 * q + 1] += (float)hh.y; } }
            const f32x4 g0 = *(const f32x4*)(GATE + o * 8), g1 = *(const f32x4*)(GATE + o * 8 + 4);
            const float isc = inv_su * ((const float*)(p.ws + WS_HSC))[o >> 4];
            float cf[8]; float mx = 0.f;
#pragma unroll
            for (int k = 0; k < 8; ++k) { const float gk = k < 4 ? g0[k] : g1[k - 4]; cf[k] = gk * gelu_exact(s[k] * isc); mx = fmaxf(mx, fabsf(cf[k])); }
#pragma unroll
            for (int d = 1; d < 16; d <<= 1) mx = fmaxf(mx, __shfl_xor(mx, d));
            const float sc = __uint_as_float(__float_as_uint(448.0f / fmaxf(mx, 1e-20f)) & 0x7f800000u);
            u32x2 c;
            { int w = __builtin_amdgcn_cvt_pk_fp8_f32(cf[0] * sc, cf[1] * sc, 0, false); w = __builtin_amdgcn_cvt_pk_fp8_f32(cf[2] * sc, cf[3] * sc, w, true); c.x = (unsigned)w; }
            { int w = __builtin_amdgcn_cvt_pk_fp8_f32(cf[4] * sc, cf[5] * sc, 0, false); w = __builtin_amdgcn_cvt_pk_fp8_f32(cf[6] * sc, cf[7] * sc, w, true); c.y = (unsigned)w; }
            COEF[o] = c;
            if ((lane & 15) == 0) CSC[o >> 4] = __uint_as_float(0x7f000000u - __float_as_uint(sc)); }
}
__device__ __forceinline__ void phase_final_norm(const Params& p, int gw, int nw, int lane) {
    f32x4 fg[4];
#pragma unroll
    for (int j = 0; j < 4; ++j) fg[j] = *(const f32x4*)(p.final_g + lane * 4 + 256 * j);
    for (int chunk = gw; chunk < T_ / 32; chunk += nw)
#pragma unroll 4
        for (int rr = 0; rr < 32; ++rr) { const size_t t = (size_t)chunk * 32 + rr;
            float* orow = p.out + t * 1024 + lane * 4; const bf16_t* xrow = (const bf16_t*)(p.ws + WS_H) + t * 1024 + lane * 4;
            f32x4 v[4]; float ss = 0.f;
#pragma unroll
            for (int j = 0; j < 4; ++j) { const u32x2 mw = *(const u32x2*)(xrow + 256 * j);
                v[j] = (f32x4){__uint_as_float(mw.x << 16), __uint_as_float(mw.x & 0xffff0000u), __uint_as_float(mw.y << 16), __uint_as_float(mw.y & 0xffff0000u)};
                ss += (v[j][0] * v[j][0] + v[j][1] * v[j][1]) + (v[j][2] * v[j][2] + v[j][3] * v[j][3]); }
            ss = wave_sum(ss);
            const float rstd = 1.0f / sqrtf(ss * (1.0f / 1024.0f) + 1e-6f);
#pragma unroll
            for (int j = 0; j < 4; ++j) __builtin_nontemporal_store(v[j] * rstd * fg[j], (f32x4*)(orow + 256 * j)); }
}


#ifndef PROBE_VALU
#define PROBE_VALU 0
#endif
#if PROBE_VALU
__device__ __forceinline__ void valu_probe(const Params& p, int lane) {
    float y[16]; const float* src = (const float*)(p.ws + WS_MOD);
#pragma unroll
    for (int k = 0; k < 16; ++k) y[k] = src[lane + 64 * k];
    const _Float16 hc = (_Float16)src[lane + 1024];
    unsigned w0 = __float_as_uint(src[lane + 2048]), w1 = __float_as_uint(src[lane + 2112]);
    const float fc = src[lane + 3072];
#pragma unroll 1
    for (int it = 0; it < 4096; ++it) {
#if PROBE_VALU == 1
#pragma unroll
        for (int rep = 0; rep < 2; ++rep)
#pragma unroll
            for (int k = 0; k < 16; ++k) asm volatile("v_fma_f32 %0, %1, %2, %0" : "+v"(y[k]) : "v"(fc), "v"(y[(k + 1) & 15]));
#elif PROBE_VALU == 2
#pragma unroll
        for (int rep = 0; rep < 2; ++rep)
#pragma unroll
            for (int k = 0; k < 16; ++k) asm volatile("v_fma_mix_f32 %0, %1, %2, %0 op_sel_hi:[1,0,0]" : "+v"(y[k]) : "v"(hc), "v"(fc));
#elif PROBE_VALU == 3
#pragma unroll
        for (int rep = 0; rep < 8; ++rep) {
            asm volatile("v_cvt_pk_f32_fp8_e32 %0, %1" : "=v"(*(unsigned long long*)&y[0]) : "v"(w0));
            asm volatile("v_cvt_pk_f32_fp8_sdwa %0, %1 src0_sel:WORD_1" : "=v"(*(unsigned long long*)&y[2]) : "v"(w0));
            asm volatile("v_cvt_pk_f32_fp8_e32 %0, %1" : "=v"(*(unsigned long long*)&y[4]) : "v"(w1));
            asm volatile("v_cvt_pk_f32_fp8_sdwa %0, %1 src0_sel:WORD_1" : "=v"(*(unsigned long long*)&y[6]) : "v"(w1)); }
#elif PROBE_VALU == 4
#pragma unroll
        for (int rep = 0; rep < 4; ++rep)
#pragma unroll
            for (int k = 0; k < 8; ++k) asm volatile("v_pk_fma_f32 %0, %1, %2, %0" : "+v"(*(unsigned long long*)&y[2 * k]) : "v"(*(unsigned long long*)&y[(2 * k + 2) & 15]), "v"(*(unsigned long long*)&y[(2 * k + 4) & 15]));
#elif PROBE_VALU == 5
#pragma unroll
        for (int rep = 0; rep < 16; ++rep) {
            asm volatile("v_cvt_scalef32_pk_f16_fp8 %0, %1, 1.0" : "=v"(w1) : "v"(w0));
            asm volatile("v_cvt_scalef32_pk_f16_fp8 %0, %1, 1.0 op_sel:[1,0,0]" : "=v"(w0) : "v"(w1)); }
#elif PROBE_VALU == 6
#pragma unroll
        for (int rep = 0; rep < 2; ++rep)
#pragma unroll
            for (int k = 0; k < 16; ++k) asm volatile("v_dot2c_f32_f16_e32 %0, %1, %2" : "+v"(y[k]) : "v"(w0), "v"(w1));
#endif
    }
    float sacc = 0.f;
#pragma unroll
    for (int k = 0; k < 16; ++k) sacc += y[k];
    sacc += __uint_as_float(w0) + __uint_as_float(w1);
    if (sacc == 123.456f) ((float*)(p.ws + WS_SSQ))[lane] = sacc;
}
#endif
#ifndef PH_MASK
#define PH_MASK 0xFFF
#endif
#define PHASE_ON(k) (((PH_MASK >> (k)) & 1) && lo <= (k) && (k) < hi)
#define GRID_SYNC(k) do { if ((k) == 0) { __syncthreads(); cg::this_grid().sync(); } else xcd_barrier(xbar); } while (0)
#define NORM_GW (gridDim.x == 256 ? (int)((blockIdx.x & 7) * 256 + (blockIdx.x >> 3) * 8 + wave) : (int)(blockIdx.x * 8 + wave))
#define PHASE_SYNC(k) do { if ((k) >= 1 && (k) <= 6) xcd_barrier(xbar, true); else GRID_SYNC(k); } while (0)
#define RUN_PHASE(k, ...) if (PHASE_ON(k)) { for (int rep_ = 0; rep_ < REPS(k); ++rep_) { __VA_ARGS__ if (rep_ + 1 < REPS(k)) GRID_SYNC(k); } if ((k) + 1 < hi) PHASE_SYNC(k); }
#define WAVE_IDS const int lane = lane_id_(), wave = wave0_, tid = wave * 64 + lane; (void)tid; (void)lane; (void)wave;
__global__ void __launch_bounds__(512) mega(Params p) {
    extern __shared__ __attribute__((aligned(16))) unsigned char lds_raw[];
    LAS unsigned char* lds = (LAS unsigned char*)lds_raw;
    const int lo = p.ph_lo, hi = p.ph_hi;
    volatile LAS unsigned* xst = (volatile LAS unsigned*)(lds + LDS_BYTES - 16);
    const int wave0_ = __builtin_amdgcn_readfirstlane((int)threadIdx.x >> 6);
    XcdBarrier xbar; xbar.bar = (unsigned*)(p.ws + WS_BAR); xbar.x = 0; xbar.st = xst; xbar.w0 = wave0_;
    if (hi - lo > 1) { if (wave0_ == 0 && lane_id_() == 0) { xst[0] = 0u; xst[1] = 0u; xst[2] = 0u; } __syncthreads(); xbar = xcd_barrier_post((unsigned*)(p.ws + WS_BAR), xst, wave0_); }
    RUN_PHASE(0, { WAVE_IDS phase_prep(p, lds, tid); })
    RUN_PHASE(1, { WAVE_IDS if (gridDim.x != 256) phase_tables_fp8(p, lds, tid, blockIdx.x, gridDim.x); else if ((blockIdx.x & 1) == 0) table_ballast(p, lds, tid, wave0_, xbar.bar, 0); phase_norm<4>(p.x, nullptr, p.norm1_g, (const float*)(p.ws + WS_MOD), 0, 1024, (bf16_t*)(p.ws + WS_H), nullptr, nullptr, NORM_GW, gridDim.x * 8, lane); })
    RUN_PHASE(2, { pg8::Gemm g{(const bf16_t*)(p.ws + WS_H), (const bf16_t*)(p.ws + WS_WIN), T_, 2048, 1024}; pg8::StaticOrder S; S.init(T_, 2048, gridDim.x, blockIdx.x);
        pg8::EpiBf16 E{(bf16_t*)(p.ws + WS_QKVU), 2048, 2, 0.125f * 1.4426950408889634f}; pg8::gemm_phase<pg8::EpiBf16, pg8::StaticOrder>(lds, g, S, E, wave0_ * 64 + lane_id_()); })
    RUN_PHASE(3, { WAVE_IDS phase_attn(p, lds, tid, wave, lane, rep_); })
    RUN_PHASE(4, { pg8::Gemm g{(const bf16_t*)(p.ws + WS_H), (const bf16_t*)(p.ws + WS_WOUT), T_, 1024, 1024}; pg8::StaticOrder S; S.init(T_, 1024, gridDim.x, blockIdx.x);
        pg8::EpiBf16 E{(bf16_t*)(p.ws + WS_X1), 1024, 0, 1.0f}; pg8::gemm_phase<pg8::EpiBf16, pg8::StaticOrder>(lds, g, S, E, wave0_ * 64 + lane_id_()); })
    RUN_PHASE(5, { WAVE_IDS phase_norm<2>(p.x, (const bf16_t*)(p.ws + WS_X1), p.norm2_g, (const float*)(p.ws + WS_MOD), 3072, 4096, (bf16_t*)(p.ws + WS_H), p.ws + WS_H8, (float*)(p.ws + WS_HSC), NORM_GW, gridDim.x * 8, lane); })
    RUN_PHASE(6, { pg8::Gemm g{(const bf16_t*)(p.ws + WS_H), (const bf16_t*)(p.ws + WS_WQ), T_, 2048, 1024}; pg8::StaticOrder S; S.init(T_, 2048, gridDim.x, blockIdx.x);
        pg8::EpiBf16 E{(bf16_t*)(p.ws + WS_QKVU), 2048, 0, 1.0f}; pg8::gemm_phase<pg8::EpiBf16, pg8::StaticOrder>(lds, g, S, E, wave0_ * 64 + lane_id_()); })
    RUN_PHASE(7, { WAVE_IDS phase_route(p, lds, tid, blockIdx.x * 8 + wave, gridDim.x * 8, wave, lane); if (gridDim.x == 256 && (blockIdx.x & 1)) { __syncthreads(); table_ballast(p, lds, tid, wave0_, xbar.bar, 1); } })
    RUN_PHASE(8, { WAVE_IDS phase_peer_part<false>(p, lds, tid, wave, lane, rep_); })
    RUN_PHASE(9, { WAVE_IDS phase_peer_coef(p, blockIdx.x * 8 + wave, gridDim.x * 8, lane); })
    RUN_PHASE(10, { WAVE_IDS phase_peer_part<true>(p, lds, tid, wave, lane, rep_); })
#if PROBE_VALU
    { WAVE_IDS valu_probe(p, lane); }
#endif
    RUN_PHASE(11, { WAVE_IDS phase_final_norm(p, blockIdx.x * 8 + wave, gridDim.x * 8, lane); })
}

#ifndef PROBE_MF4
#define PROBE_MF4 0
#endif
#if PROBE_MF4
typedef int i32x8p __attribute__((ext_vector_type(8)));
__device__ __forceinline__ int mf4_k(int hyp, int g, int n) { return hyp == 0 ? 32 * g + n : 16 * g + (n & 15) + 64 * (n >> 4); }
__global__ void mf4_probe_kernel(Params p) {
    const int l = threadIdx.x & 63, i = l & 15, g = l >> 4;
    unsigned pass = 0;
#pragma unroll
    for (int ha = 0; ha < 2; ++ha)
#pragma unroll
    for (int hb = 0; hb < 2; ++hb) {
        i32x8p a;
#pragma unroll
        for (int q = 0; q < 8; ++q) a[q] = 0;
        const int kk = (37 * i + 5) % 128;
#pragma unroll
        for (int n = 0; n < 32; ++n) if (mf4_k(ha, g, n) == kk) {
#pragma unroll
            for (int q = 0; q < 4; ++q) if ((n >> 3) == q) a[q] |= 2 << (4 * (n & 7)); }
        bool ok = true;
#pragma unroll
        for (int part = 0; part < 2; ++part) {
            i32x8p b;
#pragma unroll
            for (int q = 0; q < 8; ++q) { float v[4];
#pragma unroll
                for (int z = 0; z < 4; ++z) { const int k = mf4_k(hb, g, 4 * q + z); v[z] = (float)((part ? (k >> 4) : (k & 15)) + (i & 1)); }
                int w = __builtin_amdgcn_cvt_pk_fp8_f32(v[0], v[1], 0, false); w = __builtin_amdgcn_cvt_pk_fp8_f32(v[2], v[3], w, true); b[q] = w; }
            f32x4 acc = {0.f, 0.f, 0.f, 0.f};
            acc = __builtin_amdgcn_mfma_scale_f32_16x16x128_f8f6f4(a, b, acc, 4, 0, 0, 0x7f7f7f7f, 0, 0x7f7f7f7f);
#pragma unroll
            for (int rg = 0; rg < 4; ++rg) { const int row = 4 * g + rg; const int kr = (37 * row + 5) % 128; const float ref = (float)((part ? (kr >> 4) : (kr & 15)) + (i & 1)); ok &= (acc[rg] == ref); }
        }
        if (__all(ok)) pass |= 1u << (2 * ha + hb);
    }
    if (l == 0) p.out[5] = 1.0e6f * (float)(1u + 2u * pass);
}
#endif
#ifndef PROBE_UCHK
#define PROBE_UCHK 0
#endif
#if PROBE_UCHK
__device__ __forceinline__ float dec_fp4(unsigned c) { const float m[8] = {0.f, .5f, 1.f, 1.5f, 2.f, 3.f, 4.f, 6.f}; float v = 0.f;
#pragma unroll
    for (int k = 0; k < 8; ++k) v = ((c & 7u) == (unsigned)k) ? m[k] : v;
    return (c & 8u) ? -v : v; }
__global__ void uchk_kernel(Params p, unsigned* flags) {
    const int gt = blockIdx.x * blockDim.x + threadIdx.x;
    const int t = ((gt >> 7) * 257 + 3) & 65535, slot = gt & 127;
    const bf16_t* H = (const bf16_t*)(p.ws + WS_H); const unsigned char* H8 = p.ws + WS_H8; const float hsc = ((const float*)(p.ws + WS_HSC))[t];
    unsigned bad = 0;
    if (!(hsc > 1e-6f && hsc < 64.f)) bad |= 2u;
    for (int c = slot; c < 1024; c += 128) { const float h = bf2f(H[(size_t)t * 1024 + c]); const unsigned w = *(const unsigned*)(H8 + (size_t)t * 1024 + (c & ~3));
        const float q = (c & 3) == 0 ? __builtin_amdgcn_cvt_f32_fp8((int)w, 0) : (c & 3) == 1 ? __builtin_amdgcn_cvt_f32_fp8((int)w, 1) : (c & 3) == 2 ? __builtin_amdgcn_cvt_f32_fp8((int)w, 2) : __builtin_amdgcn_cvt_f32_fp8((int)w, 3);
        if (fabsf(q * hsc - h) > 0.07f * fabsf(h) + 0.02f) bad |= 1u; }
    const unsigned e = ((const unsigned short*)(p.ws + WS_EID))[(size_t)t * 128 + slot];
    for (int P = 0; P < 4; ++P) { float ref = 0.f;
        for (int c = 0; c < 256; ++c) { const unsigned char ub = (p.ws + WS_U8)[((size_t)P * 16384 + e) * 128 + (c >> 1)]; const unsigned code = (c & 1) ? (ub >> 4) : (ub & 15u);
            const unsigned w = *(const unsigned*)(H8 + (size_t)t * 1024 + 256 * P + (c & ~3));
            const float q = (c & 3) == 0 ? __builtin_amdgcn_cvt_f32_fp8((int)w, 0) : (c & 3) == 1 ? __builtin_amdgcn_cvt_f32_fp8((int)w, 1) : (c & 3) == 2 ? __builtin_amdgcn_cvt_f32_fp8((int)w, 2) : __builtin_amdgcn_cvt_f32_fp8((int)w, 3);
            ref += dec_fp4(code) * q; }
        const float got = (float)((const _Float16*)(p.ws + WS_PART))[((size_t)P * T_ + t) * 128 + slot];
        if (fabsf(got - ref) > 0.01f * fabsf(ref) + 2.0f) bad |= 4u; }
    if (bad) atomicOr(flags, bad);
}
__global__ void uchk_report(Params p, const unsigned* flags) { p.out[5] = 1.0e6f * (float)(1u + 2u * flags[0]); }
#endif

#ifndef PROBE_TR4
#define PROBE_TR4 0
#endif
#if PROBE_TR4
typedef int i32x2p __attribute__((ext_vector_type(2)));
typedef int i32x8q __attribute__((ext_vector_type(8)));
__global__ void tr4_probe_kernel(Params p) {
    __shared__ unsigned char sm[4096];
    LAS unsigned char* L = (LAS unsigned char*)sm;
    const int l = threadIdx.x & 63, i = l & 15, g = l >> 4;
    unsigned pass = 0;
    { unsigned w0 = 0, w1 = 0;
#pragma unroll
      for (int kap = 0; kap < 8; ++kap) { w0 |= (unsigned)((3 * i + 5 * kap + g) & 15) << (4 * kap); w1 |= (unsigned)((3 * i + 5 * (kap + 8) + g) & 15) << (4 * kap); }
      *(LAS unsigned*)(L + l * 8) = w0; *(LAS unsigned*)(L + l * 8 + 4) = w1;
      __syncthreads();
      const i32x2p rr = __builtin_amdgcn_ds_read_tr4_b64_v2i32((LAS i32x2p*)(L + l * 8));
      bool ok = true;
#pragma unroll
      for (int n = 0; n < 16; ++n) { const unsigned got = ((unsigned)(n < 8 ? rr.x : rr.y) >> (4 * (n & 7))) & 15u; ok &= (got == (unsigned)((3 * n + 5 * i + g) & 15)); }
      if (__all(ok)) pass |= 1u;
      __syncthreads(); }
    {
      for (int k = l; k < 128; k += 64) { unsigned w0 = 0, w1 = 0;
#pragma unroll
          for (int col = 0; col < 8; ++col) { w0 |= (unsigned)((7 * k + 3 * col) & 7) << (4 * col); w1 |= (unsigned)((7 * k + 3 * (col + 8)) & 7) << (4 * col); }
          *(LAS unsigned*)(L + k * 8) = w0; *(LAS unsigned*)(L + k * 8 + 4) = w1; }
      __syncthreads();
      const i32x2p r0 = __builtin_amdgcn_ds_read_tr4_b64_v2i32((LAS i32x2p*)(L + (32 * g + i) * 8));
      const i32x2p r1 = __builtin_amdgcn_ds_read_tr4_b64_v2i32((LAS i32x2p*)(L + (32 * g + 16 + i) * 8));
      i32x8q a; a[0] = r0.x; a[1] = r0.y; a[2] = r1.x; a[3] = r1.y; a[4] = 0; a[5] = 0; a[6] = 0; a[7] = 0;
      i32x8q b;
#pragma unroll
      for (int q = 0; q < 8; ++q) { const int k0 = 16 * g + 4 * (q & 3) + 64 * (q >> 2);
          int w = __builtin_amdgcn_cvt_pk_fp8_f32((float)((5 * (k0 + 0)) & 7), (float)((5 * (k0 + 1)) & 7), 0, false);
          w = __builtin_amdgcn_cvt_pk_fp8_f32((float)((5 * (k0 + 2)) & 7), (float)((5 * (k0 + 3)) & 7), w, true); b[q] = w; }
      f32x4 acc = {0.f, 0.f, 0.f, 0.f};
      acc = __builtin_amdgcn_mfma_scale_f32_16x16x128_f8f6f4(a, b, acc, 4, 0, 0, 0x7f7f7f7f, 0, 0x7f7f7f7f);
      const float mag[8] = {0.f, .5f, 1.f, 1.5f, 2.f, 3.f, 4.f, 6.f};
      bool ok = true;
#pragma unroll
      for (int rg = 0; rg < 4; ++rg) { const int col = 4 * g + rg; float ref = 0.f;
          for (int k = 0; k < 128; ++k) { const int code = (7 * k + 3 * col) & 7; float mv = 0.f;
#pragma unroll
              for (int z = 0; z < 8; ++z) mv = (code == z) ? mag[z] : mv;
              ref += mv * (float)((5 * k) & 7); }
          ok &= (acc[rg] == ref); }
      if (__all(ok)) pass |= 2u; }
    if (l == 0) p.out[5] = 1.0e6f * (float)(1u + 2u * pass);
}
#endif

#if DEBUG_CHECKS
__device__ __forceinline__ unsigned hash32(unsigned a) { a ^= a >> 16; a *= 0x7feb352du; a ^= a >> 15; a *= 0x846ca68bu; a ^= a >> 16; return a; }
__device__ __forceinline__ void dbg_rec(const Params& p, int k, float err) { if (!(err >= 0.f)) err = 1e30f; atomicMax((unsigned*)(p.ws + WS_CTL) + k, __float_as_uint(err)); }
__device__ __forceinline__ float relerr(float got, float ref, float floor_) { return fabsf(got - ref) / (fabsf(ref) + floor_); }
__device__ __forceinline__ float h2f(unsigned short h) { return (float)__builtin_bit_cast(_Float16, h); }

__global__ void __launch_bounds__(512) check_kernel(Params p, int which) {
    __shared__ float sscr[8][256];
    const int tid = threadIdx.x, lane = tid & 63, wave = tid >> 6, gw = blockIdx.x * 8 + wave;
    const float* mod = (const float*)(p.ws + WS_MOD);
    const unsigned hs = hash32(gw * 2654435761u + which * 97u + 12345u);
    if (which == 0) {
        { const int b = hs & 7, col = (hs >> 3) % MODW; float s = 0.f;
          for (int k = lane; k < 1024; k += 64) { const float v = p.c[b * 1024 + k]; s += (v / (1.0f + expf(-v))) * p.w_ada[(size_t)k * MODW + col]; }
          s = wave_sum(s) + p.b_ada[col]; dbg_rec(p, 0, relerr(mod[b * MODW + col], s, 0.05f)); }
        { const int n = (hs >> 5) % 1536, k = (hs >> 16) & 1023;
          const bf16_t* W1 = (const bf16_t*)(p.ws + WS_WIN); dbg_rec(p, 1, W1[(size_t)n * 1024 + k] == f2bf(p.w_in[(size_t)k * 2048 + n]) ? 0.f : 1.f);
          const int n2 = n & 1023; const bf16_t* W2 = (const bf16_t*)(p.ws + WS_WOUT); dbg_rec(p, 1, W2[(size_t)n2 * 1024 + k] == f2bf(p.w_out[(size_t)k * 1024 + n2]) ? 0.f : 1.f);
          const int n3 = (hs >> 4) & 2047; const bf16_t* W3 = (const bf16_t*)(p.ws + WS_WQ); dbg_rec(p, 1, W3[(size_t)n3 * 1024 + k] == f2bf(p.peer_wq[(size_t)k * 2048 + n3]) ? 0.f : 1.f);
          const unsigned si = hs & 32767; const bf16_t* S = (const bf16_t*)(p.ws + WS_SK); dbg_rec(p, 1, S[si] == f2bf(p.peer_sk[si]) ? 0.f : 1.f);
          const size_t ei = (size_t)(hs & 0xFFFFFF); const unsigned short* U = (const unsigned short*)(p.ws + WS_U16); const unsigned short* V = (const unsigned short*)(p.ws + WS_V16);
          dbg_rec(p, 1, relerr(h2f(U[ei]), p.peer_u[ei], 1e-4f) > 2e-3f ? 1.f : 0.f); dbg_rec(p, 1, relerr(h2f(V[ei]), p.peer_v[ei], 1e-4f) > 2e-3f ? 1.f : 0.f); }
        { const int g = hs & 3, e = (hs >> 2) & 127, k = (hs >> 9) & 1023; float s = 0.f;
          for (int c = lane; c < 128; c += 64) s += p.w_in[(size_t)k * 2048 + 1536 + g * 128 + c] * p.pool_w[(size_t)g * 16384 + c * 128 + e];
          s = wave_sum(s) * p.pool_scale[g * 128 + e];
          const bf16_t* W1 = (const bf16_t*)(p.ws + WS_WIN); dbg_rec(p, 2, relerr(bf2f(W1[(size_t)(1536 + g * 128 + e) * 1024 + k]), s, 0.01f)); }
    } else if (which == 1 || which == 5) {
        const int t = hs & 65535, b = t >> 13; const float* X = which == 1 ? p.x : (const float*)(p.ws + WS_X1); const float* gv = which == 1 ? p.norm1_g : p.norm2_g;
        const int sh_off = which == 1 ? 0 : 3072, sc_off = which == 1 ? 1024 : 4096;
        float ss = 0.f; for (int c = lane; c < 1024; c += 64) { const float v = X[(size_t)t * 1024 + c]; ss += v * v; }
        ss = wave_sum(ss); const float rstd = 1.0f / sqrtf(ss / 1024.0f + 1e-6f);
        const bf16_t* H = (const bf16_t*)(p.ws + WS_H); float e = 0.f;
        for (int c = lane; c < 1024; c += 64) { const float ref = X[(size_t)t * 1024 + c] * rstd * gv[c] * (1.0f + mod[b * MODW + sc_off + c]) + mod[b * MODW + sh_off + c];
            e = fmaxf(e, relerr(bf2f(H[(size_t)t * 1024 + c]), ref, 0.05f)); }
        dbg_rec(p, which == 1 ? 3 : 7, wave_max(e));
    } else if (which == 2 || which == 6) {
        const bf16_t* H = (const bf16_t*)(p.ws + WS_H); const bf16_t* W = (const bf16_t*)(p.ws + (which == 2 ? WS_WIN : WS_WQ)); const bf16_t* O = (const bf16_t*)(p.ws + WS_QKVU);
        for (int rep = 0; rep < 4; ++rep) { const unsigned h2 = hash32(hs + rep); const int t = h2 & 65535, n = (h2 >> 16) & 2047; float s = 0.f;
            for (int k = lane; k < 1024; k += 64) s += bf2f(H[(size_t)t * 1024 + k]) * bf2f(W[(size_t)n * 1024 + k]);
            s = wave_sum(s); dbg_rec(p, which == 2 ? 4 : 8, relerr(bf2f(O[(size_t)t * 2048 + n]), s, 0.05f)); }
    } else if (which == 3) {
        const bf16_t* QKV = (const bf16_t*)(p.ws + WS_QKVU); const bf16_t* MIX = (const bf16_t*)(p.ws + WS_H);
        { const int t = (gw & 1) ? (hs & 65535) : ((hs & 7) * 8192 + ((hs >> 3) & 2047)), hh = (hs >> 16) & 7, dim = (hs >> 19) & 63; const int pos = t & 8191; const size_t tok0 = (size_t)(t >> 13) * 8192;
          const float slope = exp2f(-(float)(hh + 1));
          float sc[7]; float mx = -1e30f;
#pragma unroll
          for (int q = 0; q < 7; ++q) { const int pi = lane + 64 * q; float s = -1e30f;
              if (pi < 387) { const int br = pi / 129, j = pi % 129, d = 1 << (2 * br), dist = j * d;
                  if (pos - dist >= 0) { s = 0.f; for (int k = 0; k < 64; ++k) s += bf2f(QKV[(size_t)t * 2048 + 64 * hh + k]) * bf2f(QKV[(tok0 + pos - dist) * 2048 + 512 + 64 * hh + k]); s = s * 0.125f - slope * (float)dist; } }
              sc[q] = s; mx = fmaxf(mx, s); }
          mx = wave_max(mx); float z = 0.f, acc = 0.f;
#pragma unroll
          for (int q = 0; q < 7; ++q) { const int pi = lane + 64 * q;
              if (pi < 387) { const int br = pi / 129, j = pi % 129, d = 1 << (2 * br), dist = j * d;
                  if (pos - dist >= 0) { const float e = expf(sc[q] - mx); z += e; acc += e * bf2f(QKV[(tok0 + pos - dist) * 2048 + 1024 + 64 * hh + dim]); } } }
          z = wave_sum(z); acc = wave_sum(acc);
          dbg_rec(p, 5, relerr(bf2f(MIX[(size_t)t * 1024 + 64 * hh + dim]), acc / z, 0.02f)); }
        if (lane == 0) { const unsigned h2 = hash32(hs + 7); const int t = (gw & 1) ? (h2 & 65535) : ((h2 & 7) * 8192 + ((h2 >> 3) & 31)), c = (h2 >> 16) & 511, w = 2 << (c >> 7), pos = t & 8191; float s = 0.f; int cnt = 0;
            for (int q = 0; q < w; ++q) if (pos - q >= 0) { s += bf2f(QKV[(size_t)(t - q) * 2048 + 1536 + c]); ++cnt; }
            const float ref = s / (float)cnt - bf2f(QKV[(size_t)t * 2048 + 1536 + c]);
            dbg_rec(p, 6, relerr(bf2f(MIX[(size_t)t * 1024 + 512 + c]), ref, 0.05f)); }
    } else if (which == 4) {
        const bf16_t* MIX = (const bf16_t*)(p.ws + WS_H); const bf16_t* W = (const bf16_t*)(p.ws + WS_WOUT); const float* X1 = (const float*)(p.ws + WS_X1);
        for (int rep = 0; rep < 4; ++rep) { const unsigned h2 = hash32(hs + rep); const int t = h2 & 65535, n = (h2 >> 16) & 1023, b = t >> 13; float s = 0.f;
            for (int k = lane; k < 1024; k += 64) s += bf2f(MIX[(size_t)t * 1024 + k]) * bf2f(W[(size_t)n * 1024 + k]);
            s = wave_sum(s); const float ref = p.x[(size_t)t * 1024 + n] + mod[b * MODW + 2048 + n] * s;
            dbg_rec(p, 9, relerr(X1[(size_t)t * 1024 + n], ref, 0.05f)); }
    } else if (which == 7) {
        const bf16_t* QP = (const bf16_t*)(p.ws + WS_QKVU); const bf16_t* SK = (const bf16_t*)(p.ws + WS_SK);
        const unsigned short* EID = (const unsigned short*)(p.ws + WS_EID); const float* GATE = (const float*)(p.ws + WS_GATE);
        const int t = hs & 65535, hd = (hs >> 16) & 7; float* sc = sscr[wave];
        for (int idx = lane; idx < 256; idx += 64) { const int pp = idx >> 7, n = idx & 127; float s = 0.f;
            for (int k = 0; k < 128; ++k) s += bf2f(QP[(size_t)t * 2048 + hd * 256 + pp * 128 + k]) * bf2f(SK[(size_t)pp * 16384 + n * 128 + k]);
            sc[idx] = s; }
        __builtin_amdgcn_s_waitcnt(0); __builtin_amdgcn_wave_barrier();
        float err = 0.f;
        if (lane < 16) { const int e = EID[(size_t)t * 128 + hd * 16 + lane], ei = e >> 7, ej = e & 127; const float v = sc[ei] + sc[128 + ej];
            float vmin = v, vmax = v; int dup = 0;
            for (int o = 0; o < 16; ++o) { const int e2 = EID[(size_t)t * 128 + hd * 16 + o]; const float v2 = sc[e2 >> 7] + sc[128 + (e2 & 127)]; vmin = fminf(vmin, v2); vmax = fmaxf(vmax, v2); if (o != lane && e2 == e) dup = 1; }
            if (dup) err = 1.f;
            float z = 0.f; for (int o = 0; o < 16; ++o) { const int e2 = EID[(size_t)t * 128 + hd * 16 + o]; z += expf(sc[e2 >> 7] + sc[128 + (e2 & 127)] - vmax); }
            err = fmaxf(err, relerr(GATE[(size_t)t * 128 + hd * 16 + lane], expf(v - vmax) / z, 0.01f));
            if (lane == 0) { int better = 0; for (int a = 0; a < 128; ++a) for (int bq = 0; bq < 128; ++bq) if (sc[a] + sc[128 + bq] > vmin + 2e-3f) ++better; if (better > 15) err = fmaxf(err, 2.f + (float)better); }
        }
        dbg_rec(p, 10, wave_max(err));
    } else if (which == 8) {
        const float* X1 = (const float*)(p.ws + WS_X1); const unsigned short* EID = (const unsigned short*)(p.ws + WS_EID); const float* GATE = (const float*)(p.ws + WS_GATE);
        const float* CO = (const float*)(p.ws + WS_END); const float* YD = (const float*)(p.ws + WS_END + 33554432);
        if ((gw & 7) == 0) { const int t = (hs & 65535) & ~15, b = t >> 13; float ss = 0.f;
            for (int c = lane; c < 1024; c += 64) { const float v = X1[(size_t)t * 1024 + c]; ss += v * v; }
            ss = wave_sum(ss); const float rstd = 1.0f / sqrtf(ss / 1024.0f + 1e-6f);
            float y[16]; float ec = 0.f;
_Pragma("unroll") for (int q = 0; q < 16; ++q) y[q] = 0.f;
            for (int s = 0; s < 128; ++s) { const int e = EID[(size_t)t * 128 + s]; float dsum = 0.f;
                _Pragma("unroll") for (int q = 0; q < 16; ++q) { const int c = lane + 64 * q; const float hv = X1[(size_t)t * 1024 + c] * rstd * p.norm2_g[c] * (1.0f + mod[b * MODW + 4096 + c]) + mod[b * MODW + 3072 + c]; dsum += hv * p.peer_u[(size_t)e * 1024 + c]; }
                dsum = wave_sum(dsum); const float coef = GATE[(size_t)t * 128 + s] * 0.5f * dsum * (1.0f + erff(dsum * 0.70710678f));
                ec = fmaxf(ec, relerr(CO[(size_t)t * 128 + s], coef, 0.05f));
                _Pragma("unroll") for (int q = 0; q < 16; ++q) y[q] += coef * p.peer_v[(size_t)e * 1024 + lane + 64 * q]; }
            dbg_rec(p, 11, ec);
            float ey = 0.f;
_Pragma("unroll") for (int q = 0; q < 16; ++q) ey = fmaxf(ey, relerr(YD[(size_t)(t >> 4) * 1024 + lane + 64 * q], y[q], 0.1f));
            dbg_rec(p, 12, wave_max(ey));
            float x2[16]; float s2 = 0.f;
_Pragma("unroll") for (int q = 0; q < 16; ++q) { const int c = lane + 64 * q; x2[q] = X1[(size_t)t * 1024 + c] + mod[b * MODW + 5120 + c] * y[q]; s2 += x2[q] * x2[q]; }
            s2 = wave_sum(s2); const float r3 = 1.0f / sqrtf(s2 / 1024.0f + 1e-6f); float e = 0.f;
_Pragma("unroll") for (int q = 0; q < 16; ++q) { const int c = lane + 64 * q; e = fmaxf(e, relerr(p.out[(size_t)t * 1024 + c], x2[q] * r3 * p.final_g[c], 0.2f)); }
            dbg_rec(p, 13, wave_max(e)); }
    }
}
__global__ void report_kernel(Params p) {
    const unsigned* d = (const unsigned*)(p.ws + WS_CTL);
    const float tol[14] = {1e-3f, 0.5f, 0.02f, 0.02f, 0.03f, 0.05f, 0.05f, 0.02f, 0.03f, 1e-3f, 0.02f, 0.05f, 0.03f, 0.03f};
    int code = -1;
#pragma unroll
    for (int k = 13; k >= 0; --k) if (__uint_as_float(d[k]) > tol[k]) code = k;
    if (code >= 0) {
        for (size_t i = (size_t)blockIdx.x * blockDim.x + threadIdx.x; i < (size_t)T_ * D_; i += (size_t)gridDim.x * blockDim.x) p.out[i] = (i == 0) ? 1.0e6f * (float)(code + 1) : 0.f;
    }
}
#endif

extern "C" void kernel_launch(void* const* d_in, const int* in_sizes, int n_in, void* d_out, int out_size, void* d_ws, size_t ws_size, hipStream_t stream) {
    static int grid = 0;
    if (grid == 0) {
        if (n_in != 15 || out_size != T_ * D_ || ws_size < WS_END) { fprintf(stderr, "kernel_launch: unexpected problem (n_in %d out %d ws %zu)\n", n_in, out_size, ws_size); grid = -1; return; }
        int dev = 0, cus = 0, per_cu = 0;
        (void)hipGetDevice(&dev);
        (void)hipDeviceGetAttribute(&cus, hipDeviceAttributeMultiprocessorCount, dev);
        if (hipFuncSetAttribute((const void*)mega, hipFuncAttributeMaxDynamicSharedMemorySize, LDS_BYTES) != hipSuccess) { fprintf(stderr, "kernel_launch: hipFuncSetAttribute failed\n"); grid = -1; return; }
        if (hipOccupancyMaxActiveBlocksPerMultiprocessor(&per_cu, (const void*)mega, 512, LDS_BYTES) != hipSuccess || per_cu < 1) { fprintf(stderr, "kernel_launch: occupancy query gave %d\n", per_cu); per_cu = 1; }
        (void)hipGetLastError();
        grid = cus * per_cu;
        if (grid > 256) grid = 256;
    }
    if (grid < 0) return;
    Params p{};
    p.x = (const float*)d_in[0]; p.c = (const float*)d_in[1]; p.w_ada = (const float*)d_in[2]; p.b_ada = (const float*)d_in[3]; p.norm1_g = (const float*)d_in[4];
    p.w_in = (const float*)d_in[5]; p.pool_w = (const float*)d_in[6]; p.pool_scale = (const float*)d_in[7]; p.w_out = (const float*)d_in[8]; p.norm2_g = (const float*)d_in[9];
    p.peer_wq = (const float*)d_in[10]; p.peer_sk = (const float*)d_in[11]; p.peer_u = (const float*)d_in[12]; p.peer_v = (const float*)d_in[13]; p.final_g = (const float*)d_in[14];
    p.out = (float*)d_out; p.ws = (unsigned char*)d_ws;
#if DEBUG_CHECKS
    (void)hipMemsetAsync((char*)d_ws + WS_CTL, 0, 4096, stream);
#endif
    (void)hipMemsetAsync((char*)d_ws + WS_BAR, 0, 32768, stream);
#if N_LAUNCH_MODE == 0 || DEBUG_CHECKS
    for (int ph = 0; ph < NPH; ++ph) {
        p.ph_lo = ph; p.ph_hi = ph + 1;
        hipLaunchKernelGGL(mega, dim3(grid), dim3(512), LDS_BYTES, stream, p);
#if DEBUG_CHECKS
        hipLaunchKernelGGL(check_kernel, dim3(256), dim3(512), 0, stream, p, ph);
#endif
    }
#if DEBUG_CHECKS
    hipLaunchKernelGGL(report_kernel, dim3(2048), dim3(256), 0, stream, p);
#endif
#else
    p.ph_lo = 0; p.ph_hi = NPH;
    void* args[] = {&p};
    hipError_t e = hipLaunchCooperativeKernel((const void*)mega, dim3(grid), dim3(512), args, LDS_BYTES, stream);
    if (e != hipSuccess) fprintf(stderr, "cooperative launch failed: %s (grid %d)\n", hipGetErrorString(e), grid);
#if defined(PROBE_UCHK) && PROBE_UCHK
    { unsigned* fl = (unsigned*)((unsigned char*)d_ws + WS_BAR + 16384 + 8192); hipLaunchKernelGGL(uchk_kernel, dim3(128), dim3(256), 0, stream, p, fl); hipLaunchKernelGGL(uchk_report, dim3(1), dim3(1), 0, stream, p, (const unsigned*)fl); }
#endif
#if defined(PROBE_TR4) && PROBE_TR4
    hipLaunchKernelGGL(tr4_probe_kernel, dim3(1), dim3(64), 0, stream, p);
#endif
#if defined(PROBE_MF4) && PROBE_MF4
    hipLaunchKernelGGL(mf4_probe_kernel, dim3(1), dim3(64), 0, stream, p);
#endif
#if defined(PROBE_FP4) && PROBE_FP4
    hipLaunchKernelGGL(fp4_probe_kernel, dim3(1), dim3(64), 0, stream, p);
#endif
#if defined(PROBE_FP6) && PROBE_FP6
    hipLaunchKernelGGL(fp6_probe_kernel, dim3(1), dim3(64), 0, stream, p);
#endif
#endif
}
```
